# Optimizing an MI355X kernel written in HIP

```python
import math
import jax, jax.numpy as jnp
from jax import lax
import numpy as np

D_MODEL = 2048
BATCH = 4
SEQ = 2048
DEPTH = 2

N_MIXERS = 2
N_A = (DEPTH + 1) // 2
N_B = DEPTH // 2
S5_WIDTH = D_MODEL
S5_GROUP = 16
S5_GROUPS = S5_WIDTH // S5_GROUP
S5_STATE = 64
S5_DT_MIN = 1e-3
S5_DT_MAX = 1e-1
LRU_WIDTH = ((4 * D_MODEL // 3 + 255) // 256) * 256
LRU_BLOCKS = 16
LRU_BLOCK = LRU_WIDTH // LRU_BLOCKS
LRU_C = 8.0
CONV_WIDTH = 4
FFN_HIDDEN = ((8 * D_MODEL // 3 + 255) // 256) * 256
N_MOD = 6
EPS = 1e-6

kernel_name = "adaln_hybrid_s5_rglru_swiglu"


def rmsnorm(x, gain):
    xf = x.astype(jnp.float32)
    y = xf * lax.rsqrt(jnp.mean(xf * xf, axis=-1, keepdims=True) + EPS) * gain.astype(jnp.float32)
    return y.astype(x.dtype)


def _complex_affine_combine(left, right):
    a1r, a1i, b1r, b1i = left
    a2r, a2i, b2r, b2i = right
    return (a2r * a1r - a2i * a1i,
            a2r * a1i + a2i * a1r,
            a2r * b1r - a2i * b1i + b2r,
            a2r * b1i + a2i * b1r + b2i)


def _real_affine_combine(left, right):
    a1, b1 = left
    a2, b2 = right
    return (a2 * a1, a2 * b1 + b2)


def s5_mixer(h, w_in, lam_re, lam_im, log_dt, b_re, b_im, c_re, c_im, d_skip, w_glu):
    f32 = jnp.float32
    bsz, seq, _ = h.shape
    u = h @ w_in
    uf = u.astype(f32)
    ug = uf.reshape(bsz, seq, S5_GROUPS, S5_GROUP)
    dt = jnp.exp(log_dt.astype(f32))[:, None]
    lr = lam_re.astype(f32)
    li = lam_im.astype(f32)
    mag = jnp.exp(lr * dt)
    ab_re = mag * jnp.cos(li * dt)
    ab_im = mag * jnp.sin(li * dt)
    nr, ni = ab_re - 1.0, ab_im
    den = lr * lr + li * li
    f_re = (nr * lr + ni * li) / den
    f_im = (ni * lr - nr * li) / den
    br, bi = b_re.astype(f32), b_im.astype(f32)
    bb_re = f_re[..., None] * br - f_im[..., None] * bi
    bb_im = f_re[..., None] * bi + f_im[..., None] * br
    bu_re = jnp.einsum('blgc,gpc->blgp', ug, bb_re)
    bu_im = jnp.einsum('blgc,gpc->blgp', ug, bb_im)
    a_re = jnp.broadcast_to(ab_re[None, None], (1, seq, S5_GROUPS, S5_STATE))
    a_im = jnp.broadcast_to(ab_im[None, None], (1, seq, S5_GROUPS, S5_STATE))
    _, _, s_re, s_im = lax.associative_scan(
        _complex_affine_combine, (a_re, a_im, bu_re, bu_im), axis=1)
    y = (jnp.einsum('blgp,gcp->blgc', s_re, c_re.astype(f32))
         - jnp.einsum('blgp,gcp->blgc', s_im, c_im.astype(f32)))
    y = y.reshape(bsz, seq, S5_WIDTH) + d_skip.astype(f32) * uf
    y = jax.nn.gelu(y).astype(h.dtype)
    val, gate = jnp.split(y @ w_glu, 2, axis=-1)
    return val * jax.nn.sigmoid(gate)


def causal_depthwise_conv(x, w, b):
    y = lax.conv_general_dilated(
        x, w.astype(x.dtype), window_strides=(1,), padding=[(CONV_WIDTH - 1, 0)],
        dimension_numbers=('NWC', 'WIO', 'NWC'), feature_group_count=x.shape[-1])
    return y + b.astype(x.dtype)


def rglru_mixer(h, w_in, conv_w, conv_b, w_rg, b_rg, w_ig, b_ig, lam, w_out):
    f32 = jnp.float32
    bsz, seq, _ = h.shape
    gate_branch, xb = jnp.split(h @ w_in, 2, axis=-1)
    xb = causal_depthwise_conv(xb, conv_w, conv_b).astype(f32)
    xblk = xb.reshape(bsz, seq, LRU_BLOCKS, LRU_BLOCK)
    r = jax.nn.sigmoid(jnp.einsum('blhi,hij->blhj', xblk, w_rg.astype(f32)).reshape(bsz, seq, LRU_WIDTH)
                       + b_rg.astype(f32))
    ig = jax.nn.sigmoid(jnp.einsum('blhi,hij->blhj', xblk, w_ig.astype(f32)).reshape(bsz, seq, LRU_WIDTH)
                        + b_ig.astype(f32))
    log_a = -LRU_C * r * jax.nn.softplus(-lam.astype(f32))
    a = jnp.exp(log_a)
    mult = jnp.sqrt(-jnp.expm1(2.0 * log_a))
    _, hs = lax.associative_scan(_real_affine_combine, (a, mult * (ig * xb)), axis=1)
    y = hs * jax.nn.gelu(gate_branch.astype(f32))
    return y.astype(h.dtype) @ w_out


def swiglu(h, w_gu, w_down):
    g, u = jnp.split(h @ w_gu, 2, axis=-1)
    return (jax.nn.silu(g) * u) @ w_down


def setup_inputs(seed: int = 0) -> dict:
    key = jax.random.key(seed)
    ks = jax.random.split(key, 32)
    f32 = jnp.float32
    nrm = lambda k, shape, s: jax.random.normal(k, shape, f32) * s
    D = D_MODEL
    x = nrm(ks[0], (BATCH, SEQ, D), 1.0)
    c = nrm(ks[1], (BATCH, D), 1.0)
    norm_g = 1.0 + nrm(ks[2], (DEPTH, 2, D), 0.02)
    w_ada = nrm(ks[3], (DEPTH, D, N_MOD * D), 0.5 * D ** -0.5)
    b_ada = nrm(ks[4], (DEPTH, N_MOD * D), 0.02)
    s5_w_in = nrm(ks[5], (N_A, D, S5_WIDTH), D ** -0.5)
    n = jnp.arange(S5_STATE, dtype=f32)
    s5_lam_re = -0.5 + nrm(ks[6], (N_A, S5_GROUPS, S5_STATE), 0.01)
    s5_lam_im = math.pi * n + nrm(ks[7], (N_A, S5_GROUPS, S5_STATE), 0.01)
    s5_log_dt = jax.random.uniform(ks[8], (N_A, S5_GROUPS), f32,
                                   math.log(S5_DT_MIN), math.log(S5_DT_MAX))
    s5_b_re = nrm(ks[9], (N_A, S5_GROUPS, S5_STATE, S5_GROUP), (2 * S5_GROUP) ** -0.5)
    s5_b_im = nrm(ks[10], (N_A, S5_GROUPS, S5_STATE, S5_GROUP), (2 * S5_GROUP) ** -0.5)
    s5_c_re = nrm(ks[11], (N_A, S5_GROUPS, S5_GROUP, S5_STATE), (2 * S5_STATE) ** -0.5)
    s5_c_im = nrm(ks[12], (N_A, S5_GROUPS, S5_GROUP, S5_STATE), (2 * S5_STATE) ** -0.5)
    s5_d = nrm(ks[13], (N_A, S5_WIDTH), 1.0)
    s5_w_glu = nrm(ks[14], (N_A, S5_WIDTH, 2 * D), S5_WIDTH ** -0.5)
    lru_w_in = nrm(ks[15], (N_B, D, 2 * LRU_WIDTH), D ** -0.5)
    lru_conv_w = nrm(ks[16], (N_B, CONV_WIDTH, 1, LRU_WIDTH), CONV_WIDTH ** -0.5)
    lru_conv_b = nrm(ks[17], (N_B, LRU_WIDTH), 0.02)
    lru_w_rg = nrm(ks[18], (N_B, LRU_BLOCKS, LRU_BLOCK, LRU_BLOCK), LRU_BLOCK ** -0.5)
    lru_b_rg = nrm(ks[19], (N_B, LRU_WIDTH), 0.1)
    lru_w_ig = nrm(ks[20], (N_B, LRU_BLOCKS, LRU_BLOCK, LRU_BLOCK), LRU_BLOCK ** -0.5)
    lru_b_ig = nrm(ks[21], (N_B, LRU_WIDTH), 0.1)
    a_pow = jax.random.uniform(ks[22], (N_B, LRU_WIDTH), f32, 0.9, 0.999)
    a0 = a_pow ** (1.0 / LRU_C)
    lru_lam = jnp.log(a0) - jnp.log1p(-a0)
    lru_w_out = nrm(ks[23], (N_B, LRU_WIDTH, D), LRU_WIDTH ** -0.5)
    ffn_w_gu = nrm(ks[24], (DEPTH, D, 2 * FFN_HIDDEN), D ** -0.5)
    ffn_w_down = nrm(ks[25], (DEPTH, FFN_HIDDEN, D), FFN_HIDDEN ** -0.5)
    final_g = 1.0 + nrm(ks[26], (D,), 0.02)
    return {"x": x, "c": c, "norm_g": norm_g, "w_ada": w_ada, "b_ada": b_ada,
            "s5_w_in": s5_w_in, "s5_lam_re": s5_lam_re, "s5_lam_im": s5_lam_im,
            "s5_log_dt": s5_log_dt, "s5_b_re": s5_b_re, "s5_b_im": s5_b_im,
            "s5_c_re": s5_c_re, "s5_c_im": s5_c_im, "s5_d": s5_d, "s5_w_glu": s5_w_glu,
            "lru_w_in": lru_w_in, "lru_conv_w": lru_conv_w, "lru_conv_b": lru_conv_b,
            "lru_w_rg": lru_w_rg, "lru_b_rg": lru_b_rg, "lru_w_ig": lru_w_ig,
            "lru_b_ig": lru_b_ig, "lru_lam": lru_lam, "lru_w_out": lru_w_out,
            "ffn_w_gu": ffn_w_gu, "ffn_w_down": ffn_w_down, "final_g": final_g}


def reference(x, c, norm_g, w_ada, b_ada,
              s5_w_in, s5_lam_re, s5_lam_im, s5_log_dt, s5_b_re, s5_b_im,
              s5_c_re, s5_c_im, s5_d, s5_w_glu,
              lru_w_in, lru_conv_w, lru_conv_b, lru_w_rg, lru_b_rg, lru_w_ig,
              lru_b_ig, lru_lam, lru_w_out,
              ffn_w_gu, ffn_w_down, final_g):
    cond = jax.nn.silu(c)
    for i in range(DEPTH):
        mod = cond @ w_ada[i] + b_ada[i]
        sh1, sc1, g1, sh2, sc2, g2 = [m[:, None, :] for m in jnp.split(mod, N_MOD, axis=-1)]
        h = rmsnorm(x, norm_g[i, 0]) * (1.0 + sc1) + sh1
        j = i // N_MIXERS
        if i % N_MIXERS == 0:
            y = s5_mixer(h, s5_w_in[j], s5_lam_re[j], s5_lam_im[j], s5_log_dt[j],
                         s5_b_re[j], s5_b_im[j], s5_c_re[j], s5_c_im[j], s5_d[j], s5_w_glu[j])
        else:
            y = rglru_mixer(h, lru_w_in[j], lru_conv_w[j], lru_conv_b[j], lru_w_rg[j],
                            lru_b_rg[j], lru_w_ig[j], lru_b_ig[j], lru_lam[j], lru_w_out[j])
        x = x + g1 * y
        h = rmsnorm(x, norm_g[i, 1]) * (1.0 + sc2) + sh2
        x = x + g2 * swiglu(h, ffn_w_gu[i], ffn_w_down[i])
    return rmsnorm(x, final_g)
```

```cpp
#include <hip/hip_runtime.h>
#include <hip/hip_cooperative_groups.h>
#include <cstdio>
#include <cstdint>
#define MK_N_LAUNCHES 1
namespace pg8 {
#define PG8_LAS __attribute__((address_space(3)))
typedef unsigned short bf16_t;
typedef short bf16x8 __attribute__((ext_vector_type(8)));
typedef float f32x4 __attribute__((ext_vector_type(4)));
typedef unsigned u32x4 __attribute__((ext_vector_type(4)));
constexpr int BM = 256, BK = 64, HALF = 128, HTB = HALF * BK * 2  , STAGE_BYTES = 8 * HTB, NXCD = 8, WGM = 8;

__host__ __device__ __forceinline__ int lds_byte(int r, int c) { const int st = (r >> 4) * 2 + (c >> 5), rr = r & 15, cc = c & 31, ob = rr * 64 + cc * 2; return st * 1024 + (ob ^ (((ob >> 9) & 1) << 5)); }
__host__ __device__ __forceinline__ void stage_rc(int b, int& R, int& C) { const int st = b / 1024, sb = b % 1024, swz = sb ^ (((sb >> 9) & 1) << 5); R = (st >> 1) * 16 + swz / 64; C = (st & 1) * 32 + (swz % 64) / 2; }
__host__ __device__ __forceinline__ int perm32(int rho) { const int n = rho >> 4, i = rho & 15; return 8 * (i >> 2) + 4 * n + (i & 3); }

struct Unit { int pm, pn; };
struct Gemm { const bf16_t* A; const bf16_t* Bt; int M, N, K; };

struct StaticOrder {
    int nM, nN, nwg, G, c;
    __host__ __device__ void init(int M, int N, int G_, int c_) { nM = M / BM; nN = N / BM; nwg = nM * nN; G = G_; c = c_; }
    __host__ __device__ bool next(int i, Unit& u) const {
        const long L = (long)i * G + c; if (L >= nwg) return false;
        int wgid = (int)L; { const int q = nwg / NXCD, r = nwg % NXCD, xcd = wgid % NXCD, off = wgid / NXCD; wgid = (xcd < r ? xcd * (q + 1) : r * (q + 1) + (xcd - r) * q) + off; }
        const int nig = WGM * nN, gid = wgid / nig, fm = gid * WGM, gsz = (nM - fm) < WGM ? (nM - fm) : WGM;
        u.pm = fm + ((wgid % nig) % gsz); u.pn = (wgid % nig) / gsz; return true;
    }
    __device__ __forceinline__ void a_ready(const Unit&) const {}
    __device__ __forceinline__ void done(const Unit&) const {}
};
__device__ __forceinline__ unsigned cvt_pk_bf16(float lo, float hi) { unsigned r; asm volatile("v_cvt_pk_bf16_f32 %0, %1, %2" : "=v"(r) : "v"(lo), "v"(hi)); return r; }
typedef float f32x2 __attribute__((ext_vector_type(2)));
__device__ __forceinline__ float sigmoidf_(float x) { return __builtin_amdgcn_rcpf(1.0f + __expf(-x)); }
__device__ __forceinline__ float gelu_tanh(float x) { const float u = 1.5957691216057308f * (x + 0.044715f * x * x * x); return x * sigmoidf_(u); }
constexpr int SEQ_SHIFT = 11;
constexpr int NMODP = 12288;

struct EpiS5U {
    static constexpr bool PERM = true, AFTER_DRAIN = false;
    bf16_t* UG;
    __device__ __forceinline__ void operator()(const f32x4 (&acc)[2][2][4][2], const Unit& u, int wr, int wc, int fr, int fq) const {
        const int row0 = u.pm * BM + wr * 64 + fr, colb = u.pn * BM + wc * 32 + 8 * fq;
#pragma unroll
        for (int ai = 0; ai < 2; ++ai)
#pragma unroll
            for (int m = 0; m < 4; ++m) { const int r = row0 + ai * HALF + m * 16, b = r >> SEQ_SHIFT, t = r & 2047;
#pragma unroll
                for (int bj = 0; bj < 2; ++bj) { const int c0 = colb + bj * HALF, g = c0 >> 4, hf = (c0 >> 3) & 1;
                    const f32x4 v0 = acc[ai][bj][m][0], v1 = acc[ai][bj][m][1];
                    u32x4 w; w.x = cvt_pk_bf16(v0[0], v0[1]); w.y = cvt_pk_bf16(v0[2], v0[3]); w.z = cvt_pk_bf16(v1[0], v1[1]); w.w = cvt_pk_bf16(v1[2], v1[3]);
                    *(u32x4*)(UG + ((size_t)(b * 128 + g) * 2048 + t) * 16 + 8 * hf) = w; } }
    }
};
struct EpiGluRes {
    static constexpr bool PERM = false, AFTER_DRAIN = false;
    const float* xin; float* xout; const float* gate;
    __device__ __forceinline__ void operator()(const f32x4 (&acc)[2][2][4][2], const Unit& u, int wr, int wc, int fr, int fq) const {
        const int row0 = u.pm * BM + wr * 64 + fr, j0 = u.pn * HALF + wc * 32 + 4 * fq;
#pragma unroll
        for (int ai = 0; ai < 2; ++ai)
#pragma unroll
            for (int m = 0; m < 4; ++m) { const int r = row0 + ai * HALF + m * 16, b = r >> SEQ_SHIFT;
#pragma unroll
                for (int n = 0; n < 2; ++n) { const int j = j0 + 16 * n;
                    const f32x4 xv = *(const f32x4*)(xin + (size_t)r * 2048 + j), gv = *(const f32x4*)(gate + b * NMODP + j);
                    const f32x4 va = acc[ai][0][m][n], gt = acc[ai][1][m][n]; f32x4 o;
#pragma unroll
                    for (int i = 0; i < 4; ++i) o[i] = xv[i] + gv[i] * (va[i] * sigmoidf_(gt[i]));
                    *(f32x4*)(xout + (size_t)r * 2048 + j) = o; } }
    }
};
struct EpiSwiGlu {
    static constexpr bool PERM = true, AFTER_DRAIN = false;
    bf16_t* O; int ldc;
    __device__ __forceinline__ void operator()(const f32x4 (&acc)[2][2][4][2], const Unit& u, int wr, int wc, int fr, int fq) const {
        const int row0 = u.pm * BM + wr * 64 + fr, j0 = u.pn * HALF + wc * 32 + 8 * fq;
#pragma unroll
        for (int ai = 0; ai < 2; ++ai)
#pragma unroll
            for (int m = 0; m < 4; ++m) { const int r = row0 + ai * HALF + m * 16; float o[8];
#pragma unroll
                for (int n = 0; n < 2; ++n) { const f32x4 g = acc[ai][0][m][n], uu = acc[ai][1][m][n];
#pragma unroll
                    for (int i = 0; i < 4; ++i) o[4 * n + i] = g[i] * sigmoidf_(g[i]) * uu[i]; }
                u32x4 w; w.x = cvt_pk_bf16(o[0], o[1]); w.y = cvt_pk_bf16(o[2], o[3]); w.z = cvt_pk_bf16(o[4], o[5]); w.w = cvt_pk_bf16(o[6], o[7]);
                *(u32x4*)(O + (size_t)r * ldc + j0) = w; }
    }
};
struct EpiRes {
    static constexpr bool PERM = false, AFTER_DRAIN = false;
    const float* xin; float* xout; const float* gate;
    __device__ __forceinline__ void operator()(const f32x4 (&acc)[2][2][4][2], const Unit& u, int wr, int wc, int fr, int fq) const {
        const int row0 = u.pm * BM + wr * 64 + fr, col0 = u.pn * BM + wc * 32 + 4 * fq;
#pragma unroll
        for (int ai = 0; ai < 2; ++ai)
#pragma unroll
            for (int m = 0; m < 4; ++m) { const int r = row0 + ai * HALF + m * 16, b = r >> SEQ_SHIFT;
#pragma unroll
                for (int bj = 0; bj < 2; ++bj)
#pragma unroll
                    for (int n = 0; n < 2; ++n) { const int c = col0 + bj * HALF + n * 16;
                        const f32x4 xv = *(const f32x4*)(xin + (size_t)r * 2048 + c), gv = *(const f32x4*)(gate + b * NMODP + c);
                        *(f32x4*)(xout + (size_t)r * 2048 + c) = xv + gv * acc[ai][bj][m][n]; } }
    }
};
struct EpiLruIn {
    static constexpr bool PERM = true, AFTER_DRAIN = false;
    bf16_t* GG; bf16_t* XB;
    __device__ __forceinline__ void operator()(const f32x4 (&acc)[2][2][4][2], const Unit& u, int wr, int wc, int fr, int fq) const {
        const int row0 = u.pm * BM + wr * 64 + fr; const bool isg = u.pn < 11;
        const int colb = (isg ? u.pn : u.pn - 11) * BM + wc * 32 + 8 * fq; bf16_t* base = isg ? GG : XB;
#pragma unroll
        for (int ai = 0; ai < 2; ++ai)
#pragma unroll
            for (int m = 0; m < 4; ++m) { bf16_t* rowp = base + (size_t)(row0 + ai * HALF + m * 16) * 2816 + colb;
#pragma unroll
                for (int bj = 0; bj < 2; ++bj) { f32x4 v0 = acc[ai][bj][m][0], v1 = acc[ai][bj][m][1];
                    if (isg) {
#pragma unroll
                        for (int i = 0; i < 4; ++i) { v0[i] = gelu_tanh(v0[i]); v1[i] = gelu_tanh(v1[i]); } }
                    u32x4 w; w.x = cvt_pk_bf16(v0[0], v0[1]); w.y = cvt_pk_bf16(v0[2], v0[3]); w.z = cvt_pk_bf16(v1[0], v1[1]); w.w = cvt_pk_bf16(v1[2], v1[3]);
                    *(u32x4*)(rowp + bj * HALF) = w; } }
    }
};
template <class Epi, class Sched, bool ALIGN_EPI = false, bool SP2 = false>
__device__ __forceinline__ void gemm_phase(PG8_LAS unsigned char* lds, const Gemm g, const Sched& S, const Epi& E) {
    const int tid = threadIdx.x, wid = __builtin_amdgcn_readfirstlane(tid >> 6), lane = tid & 63, wr = wid >> 2, wc = wid & 3, fr = lane & 15, fq = lane >> 4;
    const int K = g.K, nt = K / BK;
    unsigned voffA[2], voffB[2];
#pragma unroll
    for (int i = 0; i < 2; ++i) { int R, C; stage_rc(tid * 16 + i * 8192, R, C); const int Rb = Epi::PERM ? ((R & ~31) + perm32(R & 31)) : R;
        voffA[i] = (unsigned)(R * K + C) * 2u; voffB[i] = (unsigned)(Rb * K + C) * 2u; }
    const size_t kstep = (size_t)(BK * 2);
    const size_t hstep = (size_t)HALF * K * 2;
    const size_t tstep = 2 * hstep;
    const unsigned ldsw = (unsigned)wid * 1024u;
    const int aoff = lds_byte(wr * 64 + fr, fq * 8), boff = lds_byte(wc * 32 + fr, fq * 8);
#define PG8_SA(b, h) (((b) * 2 + (h)) * HTB)
#define PG8_SB(b, h) ((4 + (b) * 2 + (h)) * HTB)
#define PG8_STAGE(bufoff, gbase, voff) do { _Pragma("unroll") for (int _i = 0; _i < 2; ++_i) \
        __builtin_amdgcn_global_load_lds((const unsigned*)((const char*)(gbase) + (voff)[_i]), (PG8_LAS unsigned*)(lds + (bufoff) + ldsw + _i * 8192), 16, 0, 0); } while (0)
#define PG8_LDA(dst, b, h) do { _Pragma("unroll") for (int m = 0; m < 4; ++m) _Pragma("unroll") for (int k = 0; k < 2; ++k) dst[m][k] = *(const PG8_LAS bf16x8*)(lds + PG8_SA(b, h) + aoff + m * 2048 + k * 1024); } while (0)
#define PG8_LDB(dst, b, h) do { _Pragma("unroll") for (int n = 0; n < 2; ++n) _Pragma("unroll") for (int k = 0; k < 2; ++k) dst[n][k] = *(const PG8_LAS bf16x8*)(lds + PG8_SB(b, h) + boff + n * 2048 + k * 1024); } while (0)
#define PG8_MMA(ai, bj, At, Bt) do { __builtin_amdgcn_s_setprio(1); _Pragma("unroll") for (int m = 0; m < 4; ++m) _Pragma("unroll") for (int n = 0; n < 2; ++n) _Pragma("unroll") for (int k = 0; k < 2; ++k) \
        acc[ai][bj][m][n] = __builtin_amdgcn_mfma_f32_16x16x32_bf16(Bt[n][k], At[m][k], acc[ai][bj][m][n], 0, 0, 0); __builtin_amdgcn_s_setprio(0); } while (0)
#define PG8_WAIT_V(n) asm volatile("s_waitcnt vmcnt(" #n ")" ::: "memory")
#define PG8_WAIT_L(n) asm volatile("s_waitcnt lgkmcnt(" #n ")" ::: "memory")
#define PG8_BAR __builtin_amdgcn_s_barrier()
#define PG8_SCHED __builtin_amdgcn_sched_barrier(0)
    Unit cur, nxt; int ui = 0;
    if (!S.next(0, cur)) return;
    f32x4 acc[2][2][4][2];
#pragma unroll
    for (int a = 0; a < 2; ++a)
#pragma unroll
        for (int b = 0; b < 2; ++b)
#pragma unroll
            for (int m = 0; m < 4; ++m)
#pragma unroll
                for (int n = 0; n < 2; ++n) acc[a][b][m][n] = (f32x4){0.f, 0.f, 0.f, 0.f};
    bf16x8 At[4][2], B0[2][2], B1[2][2];
    const char* cA = (const char*)g.A + (size_t)cur.pm * tstep; const char* cB = (const char*)g.Bt + (size_t)cur.pn * tstep;
    S.a_ready(cur);
    if constexpr (SP2) {
        PG8_STAGE(PG8_SB(0, 0), cB, voffB); PG8_STAGE(PG8_SB(0, 1), cB + hstep, voffB); PG8_STAGE(PG8_SA(0, 0), cA, voffA); PG8_STAGE(PG8_SA(0, 1), cA + hstep, voffA);
        if (wr == 1) PG8_BAR;
        PG8_WAIT_V(2); PG8_BAR;
        PG8_STAGE(PG8_SB(1, 0), cB + kstep, voffB); PG8_STAGE(PG8_SA(1, 0), cA + kstep, voffA); PG8_STAGE(PG8_SB(1, 1), cB + hstep + kstep, voffB);
        PG8_WAIT_V(6); PG8_BAR;
    } else {
        PG8_STAGE(PG8_SB(0, 0), cB, voffB); PG8_STAGE(PG8_SA(0, 0), cA, voffA); PG8_STAGE(PG8_SB(0, 1), cB + hstep, voffB); PG8_STAGE(PG8_SA(0, 1), cA + hstep, voffA);
        if (wr == 1) PG8_BAR;
        PG8_WAIT_V(4); PG8_BAR;
        PG8_STAGE(PG8_SB(1, 0), cB + kstep, voffB); PG8_STAGE(PG8_SA(1, 0), cA + kstep, voffA); PG8_STAGE(PG8_SB(1, 1), cB + hstep + kstep, voffB);
        PG8_WAIT_V(6); PG8_BAR;
    }
    for (;;) {
        const bool has_next = S.next(ui + 1, nxt);
        const char* nA = has_next ? (const char*)g.A + (size_t)nxt.pm * tstep : cA; const char* nB = has_next ? (const char*)g.Bt + (size_t)nxt.pn * tstep : cB;
        for (int t = 0; t < nt; t += 2) {
            const bool last = (t == nt - 2);
            const char* a1 = cA + (size_t)(t + 1) * kstep;
            const char* a2 = last ? nA : cA + (size_t)(t + 2) * kstep; const char* b2 = last ? nB : cB + (size_t)(t + 2) * kstep;
            const char* a3 = a2 + kstep; const char* b3 = b2 + kstep;
            if (last && has_next) S.a_ready(nxt);
            if constexpr (SP2) {
            PG8_LDB(B0, 0, 0); PG8_LDB(B1, 0, 1); PG8_SCHED; PG8_LDA(At, 0, 0); PG8_STAGE(PG8_SA(1, 1), a1 + hstep, voffA);
            PG8_WAIT_V(8); PG8_WAIT_L(0); PG8_BAR; PG8_MMA(0, 0, At, B0); PG8_MMA(0, 1, At, B1); PG8_BAR; PG8_SCHED;
            PG8_LDA(At, 0, 1); PG8_STAGE(PG8_SB(0, 0), b2, voffB); PG8_STAGE(PG8_SB(0, 1), b2 + hstep, voffB); PG8_STAGE(PG8_SA(0, 0), a2, voffA);
            PG8_WAIT_V(8); PG8_WAIT_L(0); PG8_BAR; PG8_MMA(1, 0, At, B0); PG8_MMA(1, 1, At, B1); PG8_BAR; PG8_SCHED;
            PG8_LDB(B0, 1, 0); PG8_LDB(B1, 1, 1); PG8_SCHED; PG8_LDA(At, 1, 0); PG8_STAGE(PG8_SA(0, 1), a2 + hstep, voffA);
            PG8_WAIT_V(8); PG8_WAIT_L(0); PG8_BAR; PG8_MMA(0, 0, At, B0); PG8_MMA(0, 1, At, B1); PG8_BAR; PG8_SCHED;
            PG8_LDA(At, 1, 1); PG8_STAGE(PG8_SB(1, 0), b3, voffB); PG8_STAGE(PG8_SB(1, 1), b3 + hstep, voffB); PG8_STAGE(PG8_SA(1, 0), a3, voffA);
            PG8_WAIT_V(8); PG8_WAIT_L(0); PG8_BAR; PG8_MMA(1, 0, At, B0); PG8_MMA(1, 1, At, B1); PG8_BAR; PG8_SCHED;
            } else {
            PG8_LDB(B0, 0, 0); PG8_SCHED; PG8_LDA(At, 0, 0); PG8_STAGE(PG8_SA(1, 1), a1 + hstep, voffA);
            PG8_WAIT_L(8); PG8_BAR; PG8_WAIT_L(0); PG8_MMA(0, 0, At, B0); PG8_BAR; PG8_SCHED;
            PG8_LDB(B1, 0, 1); PG8_STAGE(PG8_SB(0, 0), b2, voffB);
            PG8_BAR; PG8_WAIT_L(0); PG8_MMA(0, 1, At, B1); PG8_BAR;
            PG8_LDA(At, 0, 1); PG8_STAGE(PG8_SA(0, 0), a2, voffA);
            PG8_BAR; PG8_WAIT_L(0); PG8_MMA(1, 0, At, B0); PG8_BAR; PG8_SCHED;
            PG8_STAGE(PG8_SB(0, 1), b2 + hstep, voffB);
            PG8_WAIT_V(6); PG8_BAR; PG8_MMA(1, 1, At, B1); PG8_BAR;
            PG8_LDB(B0, 1, 0); PG8_SCHED; PG8_LDA(At, 1, 0); PG8_STAGE(PG8_SA(0, 1), a2 + hstep, voffA);
            PG8_WAIT_L(8); PG8_BAR; PG8_WAIT_L(0); PG8_MMA(0, 0, At, B0); PG8_BAR; PG8_SCHED;
            PG8_LDB(B1, 1, 1); PG8_STAGE(PG8_SB(1, 0), b3, voffB);
            PG8_BAR; PG8_WAIT_L(0); PG8_MMA(0, 1, At, B1); PG8_BAR;
            PG8_LDA(At, 1, 1); PG8_STAGE(PG8_SA(1, 0), a3, voffA);
            PG8_BAR; PG8_WAIT_L(0); PG8_MMA(1, 0, At, B0); PG8_BAR; PG8_SCHED;
            PG8_STAGE(PG8_SB(1, 1), b3 + hstep, voffB);
            PG8_WAIT_V(6); PG8_BAR; PG8_MMA(1, 1, At, B1); PG8_BAR;
            }
        }
        if constexpr (ALIGN_EPI) { if (wr == 0) PG8_BAR; }
        if constexpr (!Epi::AFTER_DRAIN) { E(acc, cur, wr, wc, fr, fq); S.done(cur); }
        if (!has_next) break;
#pragma unroll
        for (int a = 0; a < 2; ++a)
#pragma unroll
            for (int b = 0; b < 2; ++b)
#pragma unroll
                for (int m = 0; m < 4; ++m)
#pragma unroll
                    for (int n = 0; n < 2; ++n) acc[a][b][m][n] = (f32x4){0.f, 0.f, 0.f, 0.f};
        cur = nxt; cA = nA; cB = nB; ++ui;
        if constexpr (ALIGN_EPI) { if (wr == 1) PG8_BAR; }
    }
    PG8_WAIT_V(0);
    if constexpr (!ALIGN_EPI) { if (wr == 0) PG8_BAR; }
    PG8_BAR;
    if constexpr (Epi::AFTER_DRAIN) { E.fused(acc, cur, wr, wc, fr, fq, lds, wid, lane); S.done(cur); }
#undef PG8_SA
#undef PG8_SB
#undef PG8_STAGE
#undef PG8_LDA
#undef PG8_LDB
#undef PG8_MMA
#undef PG8_WAIT_V
#undef PG8_WAIT_L
#undef PG8_BAR
#undef PG8_SCHED
}
}
namespace cg = cooperative_groups;
constexpr int NWAVES = 8, NTHREADS = 512;
#ifndef MK_N_LAUNCHES
#define MK_N_LAUNCHES 1
#endif
constexpr int NPHASES = 17;
constexpr int D = 2048, BATCH = 4, SEQ = 2048, M = BATCH * SEQ, NMOD = 6 * D;
constexpr int S5G = 128, S5P = 64, LRUW = 2816, LRUB = 176, FFH = 5632;
constexpr float EPS = 1e-6f;
constexpr size_t MiB = 1u << 20;
constexpr size_t WS_CTL = 0, CTL_ZERO_BYTES = 64 * 1024;
constexpr size_t WS_MOD = 1 * MiB;
constexpr size_t WS_AT = 1 * MiB + 512 * 1024;
constexpr size_t WS_BT1 = 2 * MiB;
constexpr size_t WS_BT2 = 6 * MiB;
constexpr size_t WS_WGATE = 14 * MiB;
constexpr size_t WS_WS5IN = 20 * MiB, WS_WGLU = 28 * MiB, WS_WGU0 = 44 * MiB, WS_WGU1 = 88 * MiB, WS_WDN0 = 132 * MiB, WS_WDN1 = 154 * MiB, WS_WLIN = 176 * MiB, WS_WLOUT = 198 * MiB;
constexpr size_t WS_X = 210 * MiB, WS_H = 274 * MiB, WS_SCR = 306 * MiB;
constexpr size_t WS_UG = WS_SCR, WS_Y = WS_SCR + 32 * MiB;
constexpr size_t WS_HID = WS_SCR;
constexpr size_t WS_GG = WS_SCR, WS_XB = WS_SCR + 44 * MiB, WS_P = WS_SCR + 88 * MiB, WS_Q = WS_SCR + 132 * MiB, WS_YL = WS_XB;
constexpr size_t WS_TOTG = 16 * MiB + 512 * 1024;
constexpr size_t WS_DUMMY = WS_SCR + 176 * MiB;
constexpr size_t WS_END = WS_SCR + 176 * MiB + 64 * MiB;
constexpr int LDS_BYTES = 147456, MISC_OFF = LDS_BYTES - 256;
constexpr int CW_BAR = 1024, CW_Q0 = 64;
#ifndef USE_CG_SYNC
#define USE_CG_SYNC 0
#endif

#define GAS __attribute__((address_space(1)))
#define LAS __attribute__((address_space(3)))
typedef unsigned short bf16;
typedef unsigned v4u __attribute__((ext_vector_type(4)));
typedef unsigned v2u __attribute__((ext_vector_type(2)));
typedef float f32x4 __attribute__((ext_vector_type(4)));
typedef float f32x2 __attribute__((ext_vector_type(2)));
typedef short bf16x8 __attribute__((ext_vector_type(8)));
#define LDS_WAIT() asm volatile("s_waitcnt lgkmcnt(0)" ::: "memory")
#define LDS_BARRIER() do { asm volatile("s_waitcnt lgkmcnt(0)" ::: "memory"); __builtin_amdgcn_s_barrier(); asm volatile("" ::: "memory"); } while (0)
__device__ __forceinline__ unsigned f2bf(float f) { unsigned u = __builtin_bit_cast(unsigned, f); return (u + 0x7fffu + ((u >> 16) & 1u)) >> 16; }
__device__ __forceinline__ unsigned pk2(float lo, float hi) { return f2bf(lo) | (f2bf(hi) << 16); }
__device__ __forceinline__ float bf2f(unsigned short v) { return __builtin_bit_cast(float, (unsigned)v << 16); }
__device__ __forceinline__ float wave_sum(float v) {
#pragma unroll
    for (int o = 1; o < 64; o <<= 1) v += __shfl_xor(v, o);
    return v;
}

struct Args {
    const float* in[27]; float* out; unsigned char* ws; int ph_lo, ph_hi;
};
enum { I_X = 0, I_C, I_NORMG, I_WADA, I_BADA, I_S5WIN, I_S5LRE, I_S5LIM, I_S5LDT, I_S5BRE, I_S5BIM, I_S5CRE, I_S5CIM, I_S5D, I_S5WGLU,
       I_LWIN, I_LCW, I_LCB, I_LWRG, I_LBRG, I_LWIG, I_LBIG, I_LLAM, I_LWOUT, I_FGU, I_FDN, I_FINALG };

struct Frame {
    LAS unsigned char* lds;
    int tid, lane, wave, vcu, G;
};

template <int MODE> __device__ __forceinline__ int srcmap(int n0, int F) {
    if (MODE == 0) return n0;
    const int pn = n0 >> 8, cl = n0 & 255; return cl < 128 ? 128 * pn + cl : F + 128 * pn + (cl - 128);
}
template <int MODE> __device__ __forceinline__ void p0_transpose_item(const float* W, int K, int N, int F, bf16* WT, LAS float* scr, int item, int lane) {
    const int nblk = N / 32, kb = item / nblk, nb = item % nblk, k0 = 64 * kb, n0 = 32 * nb, s0 = srcmap<MODE>(n0, F);
    float v[32];
    const float* wp = W + (size_t)(k0 + (lane >> 5)) * N + s0 + (lane & 31);
#pragma unroll
    for (int i = 0; i < 32; ++i) v[i] = wp[(size_t)(2 * i) * N];
#pragma unroll
    for (int i = 0; i < 32; ++i) scr[(2 * i + (lane >> 5)) * 33 + (lane & 31)] = v[i];
    LDS_WAIT(); asm volatile("" ::: "memory");
    const int c = lane & 7;
#pragma unroll
    for (int j = 0; j < 4; ++j) { const int n = (lane >> 3) + 8 * j; const LAS float* s = scr + (8 * c) * 33 + n;
        v4u o; o.x = pk2(s[0 * 33], s[1 * 33]); o.y = pk2(s[2 * 33], s[3 * 33]); o.z = pk2(s[4 * 33], s[5 * 33]); o.w = pk2(s[6 * 33], s[7 * 33]);
        *(GAS v4u*)(WT + (size_t)(n0 + n) * K + k0 + 8 * c) = o; }
    LDS_WAIT(); asm volatile("" ::: "memory");
}

__device__ __forceinline__ void p0_mod_item(const Frame& F, const Args& a, int item) {
    LAS float* cond = (LAS float*)F.lds;
    LAS float* red = (LAS float*)(F.lds + 32768);
    const int layer = item / 96, n0 = (item % 96) * 128;
    const float* c = a.in[I_C];
    for (int i = F.tid; i < 4 * D; i += NTHREADS) { const int b = i >> 11, k = i & 2047; const float v = c[i]; cond[k * 4 + b] = v / (1.0f + __expf(-v)); }
    __syncthreads();
    const float* W = a.in[I_WADA] + (size_t)layer * D * NMOD + n0 + 2 * F.lane;
    float acc[4][2] = {};
    const int kbeg = F.wave * 256;
#pragma unroll 16
    for (int k = kbeg; k < kbeg + 256; ++k) {
        const f32x2 w = *(const f32x2*)(W + (size_t)k * NMOD); const f32x4 cv = *(const LAS f32x4*)(cond + k * 4);
#pragma unroll
        for (int b = 0; b < 4; ++b) { acc[b][0] += cv[b] * w.x; acc[b][1] += cv[b] * w.y; }
    }
#pragma unroll
    for (int b = 0; b < 4; ++b) { red[(F.wave * 4 + b) * 128 + 2 * F.lane] = acc[b][0]; red[(F.wave * 4 + b) * 128 + 2 * F.lane + 1] = acc[b][1]; }
    __syncthreads();
    { const int b = F.tid >> 7, n = F.tid & 127; float s = a.in[I_BADA][layer * NMOD + n0 + n];
#pragma unroll
      for (int w = 0; w < 8; ++w) s += red[(w * 4 + b) * 128 + n];
      ((float*)(a.ws + WS_MOD))[(layer * 4 + b) * NMOD + n0 + n] = s; }
    __syncthreads();
}

__device__ __forceinline__ void p0_wgate_item(const Frame& F, const Args& a, int item) {
    const int h = item >> 1, gate = item & 1; bf16* dst = (bf16*)(a.ws + WS_WGATE) + (size_t)item * 176 * 192; const float* W = gate ? a.in[I_LWIG] : a.in[I_LWRG];
    for (int i = F.tid; i < 176 * 192; i += NTHREADS) { const int n = i / 192, k = i % 192; float v = 0.f; if (k < 176) v = W[((size_t)h * 176 + k) * 176 + n]; dst[i] = (bf16)f2bf(v); }
}

__device__ __forceinline__ void p0_s5prep_item(const Frame& F, const Args& a, int g) {
    LAS float* apr = (LAS float*)F.lds;
    LAS float* api = apr + 9 * 64;
    LAS float* bbr = api + 9 * 64;
    LAS float* bbi = bbr + 1024;
    LAS float* ccr = bbi + 1024;
    LAS float* cci = ccr + 1024;
    LAS float* fre = cci + 1024;
    LAS float* fim = fre + 64;
    LAS float* ktab = fim + 64;
    const int tid = F.tid;
    if (tid < 64) { const int p = tid; const float lr = a.in[I_S5LRE][g * 64 + p], li = a.in[I_S5LIM][g * 64 + p], dt = expf(a.in[I_S5LDT][g]);
        const float mag = expf(lr * dt), ang = li * dt, abr = mag * cosf(ang), abi = mag * sinf(ang), nr = abr - 1.0f, ni = abi, den = lr * lr + li * li;
        fre[p] = (nr * lr + ni * li) / den; fim[p] = (ni * lr - nr * li) / den;
        float pr = 1.f, pi = 0.f;
        for (int k = 0; k < 9; ++k) { apr[k * 64 + p] = pr; api[k * 64 + p] = pi; const float t = pr * abr - pi * abi; pi = pr * abi + pi * abr; pr = t; }
        float* at = (float*)(a.ws + WS_AT) + (g * 64 + p) * 2; at[0] = apr[8 * 64 + p]; at[1] = api[8 * 64 + p]; }
    __syncthreads();
    for (int i = tid; i < 1024; i += NTHREADS) { const int p = i >> 4; const float br = a.in[I_S5BRE][(size_t)g * 1024 + i], bi = a.in[I_S5BIM][(size_t)g * 1024 + i];
        bbr[i] = fre[p] * br - fim[p] * bi; bbi[i] = fre[p] * bi + fim[p] * br;
        ccr[i] = a.in[I_S5CRE][(size_t)g * 1024 + i]; cci[i] = a.in[I_S5CIM][(size_t)g * 1024 + i]; }
    __syncthreads();
    for (int i = tid; i < 2048; i += NTHREADS) { const int d = i >> 8, co = (i >> 4) & 15, ci = i & 15; float s = 0.f;
        for (int p = 0; p < 64; ++p) { const float cr = ccr[co * 64 + p], cim = cci[co * 64 + p], ar = apr[d * 64 + p], ai = api[d * 64 + p];
            const float er = cr * ar - cim * ai, ei = cr * ai + cim * ar; s += er * bbr[p * 16 + ci] - ei * bbi[p * 16 + ci]; }
        ktab[i] = s; }
    __syncthreads();
    { unsigned* dst = (unsigned*)((bf16*)(a.ws + WS_BT1) + (size_t)g * 128 * 128);
      for (int i = tid; i < 128 * 64; i += NTHREADS) { const int n = i >> 6, k = (i & 63) * 2, p = n & 63, im = n >> 6, t = k >> 4, c = k & 15;
          const float ar = apr[(7 - t) * 64 + p], ai = api[(7 - t) * 64 + p]; float v[2];
#pragma unroll
          for (int e = 0; e < 2; ++e) { const float br = bbr[p * 16 + c + e], bi = bbi[p * 16 + c + e]; v[e] = im ? (ar * bi + ai * br) : (ar * br - ai * bi); }
          dst[i] = pk2(v[0], v[1]); } }
    { unsigned* dst = (unsigned*)((bf16*)(a.ws + WS_BT2) + (size_t)g * 128 * 256);
      for (int i = tid; i < 128 * 128; i += NTHREADS) { const int n = i >> 7, k = (i & 127) * 2, to = n >> 4, co = n & 15; float v[2];
#pragma unroll
          for (int e = 0; e < 2; ++e) { const int kk = k + e; float x;
              if (kk < 128) { const int s = kk >> 4, ci = kk & 15, d = to - s; x = d >= 0 ? ktab[(d * 16 + co) * 16 + ci] : 0.f; if (d == 0 && ci == co) x += a.in[I_S5D][g * 16 + co]; }
              else { const int k2 = kk - 128, p = k2 & 63, im = k2 >> 6; const float cr = ccr[co * 64 + p], cim = cci[co * 64 + p], ar = apr[(to + 1) * 64 + p], ai = api[(to + 1) * 64 + p];
                  x = im ? -(cr * ai + cim * ar) : (cr * ar - cim * ai); }
              v[e] = x; }
          dst[i] = pk2(v[0], v[1]); } }
    __syncthreads();
}

__device__ __forceinline__ void p0_prologue(const Frame& F, const Args& a) {
    for (int it = F.vcu; it < 192 + 128 + 32; it += F.G) {
        if (it < 192) p0_mod_item(F, a, it);
        else if (it < 320) p0_s5prep_item(F, a, it - 192);
        else p0_wgate_item(F, a, it - 320);
    }
    __syncthreads();
    LAS float* scr = (LAS float*)(F.lds + F.wave * 16384);
    const int gw = F.vcu * NWAVES + F.wave, NGW = F.G * NWAVES;
    constexpr int I1 = (D / 64) * (D / 32), I2 = (D / 64) * (2 * D / 32), I3 = (D / 64) * (2 * FFH / 32), I4 = (FFH / 64) * (D / 32), I5 = (D / 64) * (2 * LRUW / 32), I6 = (LRUW / 64) * (D / 32);
    constexpr int NITEMS = I1 + I2 + 2 * I3 + 2 * I4 + I5 + I6;
    unsigned char* ws = a.ws;
    for (int it = gw; it < NITEMS; it += NGW) {
        int r = it;
        if (r < I1) { p0_transpose_item<0>(a.in[I_S5WIN], D, D, 0, (bf16*)(ws + WS_WS5IN), scr, r, F.lane); continue; } r -= I1;
        if (r < I2) { p0_transpose_item<1>(a.in[I_S5WGLU], D, 2 * D, D, (bf16*)(ws + WS_WGLU), scr, r, F.lane); continue; } r -= I2;
        if (r < I3) { p0_transpose_item<1>(a.in[I_FGU], D, 2 * FFH, FFH, (bf16*)(ws + WS_WGU0), scr, r, F.lane); continue; } r -= I3;
        if (r < I3) { p0_transpose_item<1>(a.in[I_FGU] + (size_t)D * 2 * FFH, D, 2 * FFH, FFH, (bf16*)(ws + WS_WGU1), scr, r, F.lane); continue; } r -= I3;
        if (r < I4) { p0_transpose_item<0>(a.in[I_FDN], FFH, D, 0, (bf16*)(ws + WS_WDN0), scr, r, F.lane); continue; } r -= I4;
        if (r < I4) { p0_transpose_item<0>(a.in[I_FDN] + (size_t)FFH * D, FFH, D, 0, (bf16*)(ws + WS_WDN1), scr, r, F.lane); continue; } r -= I4;
        if (r < I5) { p0_transpose_item<0>(a.in[I_LWIN], D, 2 * LRUW, 0, (bf16*)(ws + WS_WLIN), scr, r, F.lane); continue; } r -= I5;
        p0_transpose_item<0>(a.in[I_LWOUT], LRUW, D, 0, (bf16*)(ws + WS_WLOUT), scr, r, F.lane);
    }
}

__device__ __forceinline__ void norm_phase(const Frame& F, const float* x, const float* gain, const float* sh, const float* sc, bf16* H) {
    const int gw = F.vcu * NWAVES + F.wave, NGW = F.G * NWAVES;
    for (int r0 = gw * 4; r0 < M; r0 += NGW * 4) {
        const int b = r0 >> 11;
        f32x4 mul[8], add[8];
#pragma unroll
        for (int j = 0; j < 8; ++j) { const int k = 256 * j + 4 * F.lane; const f32x4 g = *(const f32x4*)(gain + k), s = *(const f32x4*)(sc + b * NMOD + k); mul[j] = g * (1.0f + s); add[j] = *(const f32x4*)(sh + b * NMOD + k); }
        for (int rr = 0; rr < 4; ++rr) { const int r = r0 + rr; const f32x4* xr = (const f32x4*)(x + (size_t)r * D) + F.lane;
            f32x4 v[8]; float s = 0.f;
#pragma unroll
            for (int j = 0; j < 8; ++j) { v[j] = xr[64 * j]; s += (v[j].x * v[j].x + v[j].y * v[j].y) + (v[j].z * v[j].z + v[j].w * v[j].w); }
            const float rstd = 1.0f / sqrtf(wave_sum(s) * (1.0f / D) + EPS);
            v2u* o = (v2u*)(H + (size_t)r * D) + F.lane;
#pragma unroll
            for (int j = 0; j < 8; ++j) { const f32x4 y = v[j] * rstd * mul[j] + add[j]; v2u w; w.x = pk2(y.x, y.y); w.y = pk2(y.z, y.w); o[64 * j] = w; } }
    }
}
__device__ __forceinline__ void final_norm_phase(const Frame& F, const float* x, const float* gain, float* out) {
    const int gw = F.vcu * NWAVES + F.wave, NGW = F.G * NWAVES;
    for (int r = gw; r < M; r += NGW) { const f32x4* xr = (const f32x4*)(x + (size_t)r * D) + F.lane;
        f32x4 v[8]; float s = 0.f;
#pragma unroll
        for (int j = 0; j < 8; ++j) { v[j] = xr[64 * j]; s += (v[j].x * v[j].x + v[j].y * v[j].y) + (v[j].z * v[j].z + v[j].w * v[j].w); }
        const float rstd = 1.0f / sqrtf(wave_sum(s) * (1.0f / D) + EPS);
        f32x4* o = (f32x4*)(out + (size_t)r * D) + F.lane;
#pragma unroll
        for (int j = 0; j < 8; ++j) o[64 * j] = v[j] * rstd * *(const f32x4*)(gain + 256 * j + 4 * F.lane); }
}

constexpr int S5_UP = 272, S5_SP = 528, S5_SOFF = 128 * S5_UP;
__device__ __forceinline__ void s5_item(const Frame& F, const Args& a, int item) {
    const int b = item >> 7, g = item & 127, w = F.wave, lane = F.lane, fr = lane & 15, fq = lane >> 4;
    LAS unsigned char* Uc = F.lds; LAS unsigned char* S = F.lds + S5_SOFF;
    const bf16* Bt1 = (const bf16*)(a.ws + WS_BT1) + (size_t)g * 128 * 128; const bf16* Bt2 = (const bf16*)(a.ws + WS_BT2) + (size_t)g * 128 * 256;
    bf16x8 B1[4], B2[8];
#pragma unroll
    for (int kk = 0; kk < 4; ++kk) B1[kk] = *(const bf16x8*)(Bt1 + (16 * w + fr) * 128 + 32 * kk + 8 * fq);
#pragma unroll
    for (int kk = 0; kk < 8; ++kk) B2[kk] = *(const bf16x8*)(Bt2 + (16 * w + fr) * 256 + 32 * kk + 8 * fq);
    float aTr = 0.f, aTi = 0.f, sr = 0.f, si = 0.f;
    if (w == 0) { const float* at = (const float*)(a.ws + WS_AT) + (g * 64 + lane) * 2; aTr = at[0]; aTi = at[1]; }
    const bf16* UG = (const bf16*)(a.ws + WS_UG) + (size_t)(b * 128 + g) * 2048 * 16;
    bf16* Y = (bf16*)(a.ws + WS_Y);
    for (int hf = 0; hf < 2; ++hf) {
        const v4u* src = (const v4u*)(UG + (size_t)hf * 1024 * 16);
#pragma unroll
        for (int i = 0; i < 4; ++i) { const int piece = F.tid + 512 * i, row = piece >> 4, c16 = piece & 15; *(LAS v4u*)(Uc + row * S5_UP + c16 * 16) = src[piece]; }
        LDS_BARRIER();
#pragma unroll 2
        for (int mt = 0; mt < 8; ++mt) { f32x4 acc = {0.f, 0.f, 0.f, 0.f};
#pragma unroll
            for (int kk = 0; kk < 4; ++kk) { const bf16x8 av = *(const LAS bf16x8*)(Uc + (16 * mt + fr) * S5_UP + (32 * kk + 8 * fq) * 2); acc = __builtin_amdgcn_mfma_f32_16x16x32_bf16(B1[kk], av, acc, 0, 0, 0); }
            *(LAS f32x4*)(S + (16 * mt + fr) * S5_SP + (16 * w + 4 * fq) * 4) = acc; }
        LDS_BARRIER();
        if (w == 0) {
            for (int j0 = 0; j0 < 128; j0 += 8) { float er[8], ei[8];
#pragma unroll
                for (int q = 0; q < 8; ++q) { LAS unsigned char* row = S + (j0 + q) * S5_SP; er[q] = *(const LAS float*)(row + 4 * lane); ei[q] = *(const LAS float*)(row + 256 + 4 * lane); }
                asm volatile("s_waitcnt lgkmcnt(0)" ::: "memory");
#pragma unroll
                for (int q = 0; q < 8; ++q) { LAS unsigned char* row = S + (j0 + q) * S5_SP;
                    *(LAS bf16*)(row + 2 * lane) = (bf16)f2bf(sr); *(LAS bf16*)(row + 128 + 2 * lane) = (bf16)f2bf(si);
                    const float nr = aTr * sr - aTi * si + er[q], ni = aTr * si + aTi * sr + ei[q]; sr = nr; si = ni; } }
        }
        LDS_BARRIER();
#pragma unroll 2
        for (int mt = 0; mt < 8; ++mt) { f32x4 acc = {0.f, 0.f, 0.f, 0.f};
#pragma unroll
            for (int kk = 0; kk < 4; ++kk) { const bf16x8 av = *(const LAS bf16x8*)(Uc + (16 * mt + fr) * S5_UP + (32 * kk + 8 * fq) * 2); acc = __builtin_amdgcn_mfma_f32_16x16x32_bf16(B2[kk], av, acc, 0, 0, 0); }
#pragma unroll
            for (int kk = 0; kk < 4; ++kk) { const bf16x8 av = *(const LAS bf16x8*)(S + (16 * mt + fr) * S5_SP + (32 * kk + 8 * fq) * 2); acc = __builtin_amdgcn_mfma_f32_16x16x32_bf16(B2[4 + kk], av, acc, 0, 0, 0); }
            const int tok = b * 2048 + hf * 1024 + 8 * (16 * mt + fr) + w;
            v2u o; o.x = pk2(pg8::gelu_tanh(acc[0]), pg8::gelu_tanh(acc[1])); o.y = pk2(pg8::gelu_tanh(acc[2]), pg8::gelu_tanh(acc[3]));
            *(v2u*)(Y + (size_t)tok * D + 16 * g + 4 * fq) = o; }
        LDS_BARRIER();
    }
}

constexpr int L_AP = 400, L_ABUF = 128 * L_AP, L_SP = 352, L_PS = L_ABUF, L_QS = L_PS + 128 * L_SP, L_CONST = L_QS + 128 * L_SP;
static_assert(L_CONST + 176 * 16 <= MISC_OFF, "LRU LDS map");
template <int CTRL> __device__ __forceinline__ float dpp_f(float old, float src) { return __builtin_bit_cast(float, __builtin_amdgcn_update_dpp(__builtin_bit_cast(int, old), __builtin_bit_cast(int, src), CTRL, 0xf, 0xf, false)); }
__device__ __forceinline__ void lruA_phase(const Frame& F, const Args& a) {
    const int w = F.wave, lane = F.lane, fr = lane & 15, fq = lane >> 4, tid = F.tid;
    const int h = F.vcu & 15;
    LAS float* CONST = (LAS float*)(F.lds + L_CONST);
    for (int i = tid; i < 176; i += NTHREADS) { const int ch = 176 * h + i; const float lam = a.in[I_LLAM][ch]; const float sp = lam < -20.f ? -lam : log1pf(expf(-lam));
        CONST[4 * i] = -8.0f * sp; CONST[4 * i + 1] = a.in[I_LBRG][ch]; CONST[4 * i + 2] = a.in[I_LBIG][ch]; CONST[4 * i + 3] = 0.f; }
    for (int i = tid; i < 128 * 2; i += NTHREADS) { const int row = i >> 1, c16 = i & 1; *(LAS v4u*)(F.lds + row * L_AP + 352 + c16 * 16) = (v4u){0u, 0u, 0u, 0u}; }
    const int quad = tid % 44, rg8 = tid / 44;
    float cw[4][4], cb[4];
    if (tid < 352) {
#pragma unroll
        for (int i = 0; i < 4; ++i) { const int ch = 176 * h + 4 * quad + i; cb[i] = a.in[I_LCB][ch];
#pragma unroll
            for (int k = 0; k < 4; ++k) cw[k][i] = a.in[I_LCW][k * LRUW + ch]; } }
    const bf16* XB = (const bf16*)(a.ws + WS_XB); const bf16* GG = (const bf16*)(a.ws + WS_GG); bf16* PB = (bf16*)(a.ws + WS_P); bf16* QB = (bf16*)(a.ws + WS_Q);
    f32x2* TOTG = (f32x2*)(a.ws + WS_TOTG);
    const bf16* WG2 = (const bf16*)(a.ws + WS_WGATE) + (size_t)h * 2 * 176 * 192;
    const int mg = w >> 2, cs = w & 3, ct0 = 3 * cs, ct1 = cs < 3 ? ct0 + 3 : 11;
    v2u raw[19]; bf16x8 wr[6], wi[6]; v2u ggn[4];
#define LRU_LOAD_RAW(ITEM) do { const int tix_ = (ITEM) >> 4, b_ = tix_ >> 4, tb_ = (tix_ & 15) * 128 + 16 * rg8; \
        const bf16* src_ = XB + (size_t)(b_ * 2048 + tb_ - 3) * LRUW + 176 * h + 4 * quad; \
        _Pragma("unroll") for (int r = 0; r < 19; ++r) { raw[r] = (v2u){0u, 0u}; if (tb_ - 3 + r >= 0) raw[r] = *(const v2u*)(src_ + (size_t)r * LRUW); } } while (0)
#define LRU_CONV(ABUF) do { _Pragma("unroll") for (int r = 0; r < 16; ++r) { float o[4] = {cb[0], cb[1], cb[2], cb[3]}; \
            _Pragma("unroll") for (int k = 0; k < 4; ++k) { const v2u v = raw[r + k]; \
                o[0] += cw[k][0] * bf2f((unsigned short)(v.x & 0xffffu)); o[1] += cw[k][1] * bf2f((unsigned short)(v.x >> 16)); \
                o[2] += cw[k][2] * bf2f((unsigned short)(v.y & 0xffffu)); o[3] += cw[k][3] * bf2f((unsigned short)(v.y >> 16)); } \
            v2u ov; ov.x = pk2(o[0], o[1]); ov.y = pk2(o[2], o[3]); *(LAS v2u*)((ABUF) + (16 * rg8 + r) * L_AP + quad * 8) = ov; } } while (0)
#define LRU_LOAD_W(CT) do { _Pragma("unroll") for (int kk = 0; kk < 6; ++kk) { wr[kk] = *(const bf16x8*)(WG2 + (size_t)(16 * (CT) + fr) * 192 + 32 * kk + 8 * fq); \
            wi[kk] = *(const bf16x8*)(WG2 + (size_t)(176 + 16 * (CT) + fr) * 192 + 32 * kk + 8 * fq); } } while (0)
#define LRU_LOAD_GG(ITEM, CT) do { const int tix_ = (ITEM) >> 4; const size_t tokb_ = (size_t)((tix_ >> 4) * 2048 + (tix_ & 15) * 128 + 64 * mg + fr); \
        _Pragma("unroll") for (int mt = 0; mt < 4; ++mt) ggn[mt] = *(const v2u*)(GG + (tokb_ + 16 * mt) * LRUW + 176 * h + 16 * (CT) + 4 * fq); } while (0)
    if (F.vcu < 1024) { if (tid < 352) { LRU_LOAD_RAW(F.vcu); LRU_CONV(F.lds); } LRU_LOAD_W(ct0); LRU_LOAD_GG(F.vcu, ct0); }
    __syncthreads();
    int it_n = 0;
    for (int item = F.vcu; item < 1024; item += F.G, ++it_n) {
        const int tix = item >> 4, b = tix >> 4, tile = tix & 15, t0 = tile * 128;
        const int nitem = item + F.G; const bool has_next = nitem < 1024;
        LAS unsigned char* A = F.lds;
        if (has_next && tid < 352) LRU_LOAD_RAW(nitem);
        const int chunk = tile * 2 + mg;
        for (int ct = ct0; ct < ct1; ++ct) {
            const size_t tokb = (size_t)(b * 2048 + t0 + 64 * mg + fr);
            const int chb = 176 * h + 16 * ct + 4 * fq;
            v2u ggr[4];
#pragma unroll
            for (int mt = 0; mt < 4; ++mt) ggr[mt] = ggn[mt];
            f32x4 ar[4], ai[4];
#pragma unroll
            for (int mt = 0; mt < 4; ++mt) { ar[mt] = (f32x4){0.f, 0.f, 0.f, 0.f}; ai[mt] = (f32x4){0.f, 0.f, 0.f, 0.f}; }
#pragma unroll
            for (int kk = 0; kk < 6; ++kk)
#pragma unroll
                for (int mt = 0; mt < 4; ++mt) { const bf16x8 av = *(const LAS bf16x8*)(A + (64 * mg + 16 * mt + fr) * L_AP + (32 * kk + 8 * fq) * 2);
                    ar[mt] = __builtin_amdgcn_mfma_f32_16x16x32_bf16(wr[kk], av, ar[mt], 0, 0, 0); ai[mt] = __builtin_amdgcn_mfma_f32_16x16x32_bf16(wi[kk], av, ai[mt], 0, 0, 0); }
            { const bool more = ct + 1 < ct1; const int nct = more ? ct + 1 : ct0;
              asm volatile("" : "+v"(ar[3]), "+v"(ai[3]));
              LRU_LOAD_W(nct); if (more) LRU_LOAD_GG(item, nct); else if (has_next) LRU_LOAD_GG(nitem, nct); }
            f32x4 cst[4];
#pragma unroll
            for (int i = 0; i < 4; ++i) cst[i] = *(const LAS f32x4*)(CONST + 4 * (16 * ct + 4 * fq + i));
            float Ac[4] = {1.f, 1.f, 1.f, 1.f}, Bc[4] = {0.f, 0.f, 0.f, 0.f};
#pragma unroll
            for (int mt = 0; mt < 4; ++mt) {
                const v2u xr = *(const LAS v2u*)(A + (64 * mg + 16 * mt + fr) * L_AP + (16 * ct + 4 * fq) * 2);
                const float xc[4] = {bf2f((unsigned short)(xr.x & 0xffffu)), bf2f((unsigned short)(xr.x >> 16)), bf2f((unsigned short)(xr.y & 0xffffu)), bf2f((unsigned short)(xr.y >> 16))};
                const float gg[4] = {bf2f((unsigned short)(ggr[mt].x & 0xffffu)), bf2f((unsigned short)(ggr[mt].x >> 16)), bf2f((unsigned short)(ggr[mt].y & 0xffffu)), bf2f((unsigned short)(ggr[mt].y >> 16))};
                float P4[4], Q4[4], av[4], bv[4];
#pragma unroll
                for (int i = 0; i < 4; ++i) {
                    const float r = pg8::sigmoidf_(ar[mt][i] + cst[i].y), ig = pg8::sigmoidf_(ai[mt][i] + cst[i].z);
                    const float la = cst[i].x * r, x2 = 2.0f * la;
                    av[i] = __expf(la);
                    const float em1 = x2 * (1.0f + x2 * (0.5f + x2 * (0.16666667f + x2 * (0.041666668f + x2 * 0.0083333338f))));
                    bv[i] = __builtin_amdgcn_sqrtf(-em1) * ig * xc[i];
                }
#define LRU_DPP_STEP(S) \
                    "v_fmac_f32_dpp %4, %4, %0 row_shr:" #S " row_mask:0xf bank_mask:0xf\n\t" "v_fmac_f32_dpp %5, %5, %1 row_shr:" #S " row_mask:0xf bank_mask:0xf\n\t" \
                    "v_fmac_f32_dpp %6, %6, %2 row_shr:" #S " row_mask:0xf bank_mask:0xf\n\t" "v_fmac_f32_dpp %7, %7, %3 row_shr:" #S " row_mask:0xf bank_mask:0xf\n\t" \
                    "v_mul_f32_dpp %0, %0, %0 row_shr:" #S " row_mask:0xf bank_mask:0xf\n\t" "v_mul_f32_dpp %1, %1, %1 row_shr:" #S " row_mask:0xf bank_mask:0xf\n\t" \
                    "v_mul_f32_dpp %2, %2, %2 row_shr:" #S " row_mask:0xf bank_mask:0xf\n\t" "v_mul_f32_dpp %3, %3, %3 row_shr:" #S " row_mask:0xf bank_mask:0xf\n\t"
                asm volatile("s_nop 1\n\t" LRU_DPP_STEP(1) LRU_DPP_STEP(2) LRU_DPP_STEP(4) LRU_DPP_STEP(8) "s_nop 1"
                             : "+v"(av[0]), "+v"(av[1]), "+v"(av[2]), "+v"(av[3]), "+v"(bv[0]), "+v"(bv[1]), "+v"(bv[2]), "+v"(bv[3]));
#undef LRU_DPP_STEP
#pragma unroll
                for (int i = 0; i < 4; ++i) {
                    const float hl = bv[i] + av[i] * Bc[i], ca = av[i] * Ac[i];
                    Ac[i] = __shfl(ca, 15, 16); Bc[i] = __shfl(hl, 15, 16);
                    P4[i] = hl * gg[i]; Q4[i] = ca * gg[i];
                }
                v2u po, qo; po.x = pk2(P4[0], P4[1]); po.y = pk2(P4[2], P4[3]); qo.x = pk2(Q4[0], Q4[1]); qo.y = pk2(Q4[2], Q4[3]);
                const int so = (64 * mg + 16 * mt + fr) * L_SP + (16 * ct + 4 * fq) * 2;
                *(LAS v2u*)(F.lds + L_PS + so) = po; *(LAS v2u*)(F.lds + L_QS + so) = qo;
            }
            if (fr == 15) {
#pragma unroll
                for (int i = 0; i < 4; ++i) TOTG[(size_t)(b * 32 + chunk) * LRUW + chb + i] = (f32x2){Ac[i], Bc[i]}; }
        }
        LDS_BARRIER();
        if (has_next && tid < 352) LRU_CONV(F.lds);
#pragma unroll
        for (int j = 0; j < 11; ++j) { const int p = tid + NTHREADS * j, which = p >= 2816, pp = which ? p - 2816 : p, row = pp / 22, c16 = pp % 22;
            const v4u v = *(const LAS v4u*)(F.lds + (which ? L_QS : L_PS) + row * L_SP + c16 * 16);
            *(v4u*)((which ? QB : PB) + (size_t)(b * 2048 + t0 + row) * LRUW + 176 * h + 8 * c16) = v; }
        LDS_BARRIER();
    }
#undef LRU_LOAD_RAW
#undef LRU_CONV
#undef LRU_LOAD_W
#undef LRU_LOAD_GG
}
__device__ __forceinline__ void lruB_phase(const Frame& F, const Args& a) {
    const bf16* PB = (const bf16*)(a.ws + WS_P); const bf16* QB = (const bf16*)(a.ws + WS_Q); bf16* YL = (bf16*)(a.ws + WS_YL);
    const f32x4* TOTG = (const f32x4*)(a.ws + WS_TOTG);
    const int NIT = BATCH * 32 * 2 * 352, gt = F.vcu * NTHREADS + F.tid, NT = F.G * NTHREADS;
    for (int it = gt; it < NIT; it += NT) {
        const int cg = it % 352, r1 = it / 352, tq = r1 & 1, r2 = r1 >> 1, chunk = r2 & 31, b = r2 >> 5;
        float hin[8] = {0.f, 0.f, 0.f, 0.f, 0.f, 0.f, 0.f, 0.f};
        for (int jj = 0; jj < chunk; ++jj) { const f32x4* t = TOTG + ((size_t)(b * 32 + jj) * LRUW + 8 * cg) / 2;
#pragma unroll
            for (int e = 0; e < 4; ++e) { const f32x4 v = t[e]; hin[2 * e] = v.x * hin[2 * e] + v.y; hin[2 * e + 1] = v.z * hin[2 * e + 1] + v.w; } }
        const size_t base = (size_t)(b * 2048 + chunk * 64 + tq * 32) * LRUW + 8 * cg;
#pragma unroll 8
        for (int tt = 0; tt < 32; ++tt) { const v4u p = *(const v4u*)(PB + base + (size_t)tt * LRUW), q = *(const v4u*)(QB + base + (size_t)tt * LRUW); v4u o;
#pragma unroll
            for (int e = 0; e < 4; ++e) { const unsigned pw = p[e], qw = q[e];
                const float y0 = bf2f((unsigned short)(pw & 0xffffu)) + bf2f((unsigned short)(qw & 0xffffu)) * hin[2 * e], y1 = bf2f((unsigned short)(pw >> 16)) + bf2f((unsigned short)(qw >> 16)) * hin[2 * e + 1];
                o[e] = pk2(y0, y1); }
            *(v4u*)(YL + base + (size_t)tt * LRUW) = o; }
    }
}
#define XB_TMO      128
#define XB_XCNT(j)  (256  + 64 * (j))
#define XB_XSUB(j)  (1280 + 64 * (j))
#define XB_XGEN(j)  (2304 + 64 * (j))
#define XB_TOP      3328
#define XB_TOPGEN   3392
#define XCD_BAR_WORDS 3456
#define XB_SPIN_CAP (1u << 18)

__device__ __forceinline__ unsigned xb_ld(unsigned* p)              { return __hip_atomic_load(p, __ATOMIC_RELAXED, __HIP_MEMORY_SCOPE_AGENT); }
__device__ __forceinline__ unsigned xb_add(unsigned* p, unsigned v) { return __hip_atomic_fetch_add(p, v, __ATOMIC_RELAXED, __HIP_MEMORY_SCOPE_AGENT); }
__device__ __forceinline__ unsigned xb_xcc_id() { return (unsigned)__builtin_amdgcn_s_getreg((3 << 11) | 20) & 0xFu; }
#define XB_SPIN(cond, bar) do { unsigned _sp = 0; while (cond) { __builtin_amdgcn_s_sleep(1); \
    if ((++_sp & 255u) == 0u) { if (xb_ld(&(bar)[XB_TMO])) break; if (_sp > XB_SPIN_CAP) { atomicAdd(&(bar)[XB_TMO], 1u); break; } } } } while (0)

struct XcdBarrier {
    unsigned* bar; unsigned x;
    volatile LAS unsigned* st;
};

__device__ __forceinline__ XcdBarrier xcd_barrier_post(unsigned* bar, volatile LAS unsigned* st) {
    XcdBarrier b; b.bar = bar; b.x = xb_xcc_id(); b.st = st;
    if (threadIdx.x == 0) (void)xb_add(&bar[XB_XCNT(b.x)], 1u);
    return b;
}
__device__ __forceinline__ void xcd_barrier_complete(unsigned* bar, unsigned x, unsigned& nloc, unsigned& nx) {
    const unsigned G = gridDim.x * gridDim.y * gridDim.z;
    unsigned sum, cnt, mine, sp = 0u;
    for (;;) {
        sum = 0u; cnt = 0u; mine = 0u;
#pragma unroll
        for (unsigned j = 0; j < 16; ++j) { const unsigned c = xb_ld(&bar[XB_XCNT(j)]); sum += c; cnt += (c > 0u) ? 1u : 0u; mine = (j == x) ? c : mine; }
        if (sum == G) break;
        __builtin_amdgcn_s_sleep(1);
        if ((++sp & 255u) == 0u) { if (xb_ld(&bar[XB_TMO])) break; if (sp > XB_SPIN_CAP) { atomicAdd(&bar[XB_TMO], 1u); break; } }
    }
    nloc = mine > 0u ? mine : 1u; nx = cnt > 0u ? cnt : 1u;
}

__device__ __forceinline__ void xcd_barrier(const XcdBarrier& b) {
    asm volatile("s_waitcnt vmcnt(0)" ::: "memory");
    __syncthreads();
    if (threadIdx.x == 0) {
        unsigned* bar = b.bar;
        __builtin_amdgcn_s_waitcnt(0);
        unsigned nloc = b.st[0], nx = b.st[1];
        if (nloc == 0u) { xcd_barrier_complete(bar, b.x, nloc, nx); b.st[0] = nloc; b.st[1] = nx; }
        const unsigned old = xb_add(&bar[XB_XSUB(b.x)], 1u);
        const unsigned gen = old / nloc;
        if (old + 1u == (gen + 1u) * nloc) {
            __builtin_amdgcn_fence(__ATOMIC_RELEASE, "agent");
            asm volatile("s_waitcnt vmcnt(0)" ::: "memory");
            const unsigned og = xb_add(&bar[XB_TOP], 1u);
            const unsigned tg = og / nx;
            if (og + 1u == (tg + 1u) * nx) xb_add(&bar[XB_TOPGEN], 1u);
            else XB_SPIN(xb_ld(&bar[XB_TOPGEN]) == tg, bar);
            __builtin_amdgcn_fence(__ATOMIC_ACQUIRE, "agent");
            xb_add(&bar[XB_XGEN(b.x)], 1u);
            asm volatile("s_waitcnt vmcnt(0)" ::: "memory");
        } else {
            XB_SPIN(xb_ld(&bar[XB_XGEN(b.x)]) == gen, bar);
            __builtin_amdgcn_fence(__ATOMIC_ACQUIRE, "agent");
            asm volatile("s_waitcnt vmcnt(0)" ::: "memory");
        }
    }
    __syncthreads();
}
__global__ void __launch_bounds__(NTHREADS, 2) fwd_kernel(Args args) {
    extern __shared__ __attribute__((aligned(16))) unsigned char lds[];
    Frame F;
    F.lds = (LAS unsigned char*)lds;
    F.tid = threadIdx.x; F.lane = F.tid & 63; F.wave = __builtin_amdgcn_readfirstlane(F.tid >> 6);
    F.G = gridDim.x; { const int bx = blockIdx.x; F.vcu = (F.G % 8 == 0) ? (bx % 8) * (F.G / 8) + bx / 8 : bx; }
    unsigned char* ws = args.ws;
    const int lo = args.ph_lo, hi = args.ph_hi;
#if MK_N_LAUNCHES == 1
    volatile LAS unsigned* MISC = (volatile LAS unsigned*)(F.lds + MISC_OFF);
    if (F.tid < 8) MISC[F.tid] = 0u;
    __syncthreads();
    XcdBarrier bar = xcd_barrier_post((unsigned*)(ws + WS_CTL) + CW_BAR, MISC);
#if USE_CG_SYNC
    cg::grid_group grid = cg::this_grid();
#define GRID_BAR() grid.sync()
#else
#define GRID_BAR() xcd_barrier(bar)
#endif
#else
#define GRID_BAR() do {} while (0)
#endif
#define IN(k) (lo <= (k) && (k) < hi)
#ifndef PROBE_MASK
#define PROBE_MASK 0
#endif
#define NREP(k) (1 + ((PROBE_MASK >> (k)) & 1))
#define LASTREP(k) (rep_ + 1 == NREP(k))
#define FORREP(k) for (int rep_ = 0; rep_ < NREP(k); ++rep_, (rep_ < NREP(k) ? (GRID_BAR(), 0) : 0))
    float* XD = (float*)(ws + WS_DUMMY);
#ifdef PROBE_BAR2
#define SEAM(k) do { if (IN(k) && IN((k) + 1)) { GRID_BAR(); GRID_BAR(); } } while (0)
#else
#define SEAM(k) do { if (IN(k) && IN((k) + 1)) GRID_BAR(); } while (0)
#endif
    const float* mod = (const float*)(ws + WS_MOD);
    float* X = (float*)(ws + WS_X); bf16* H = (bf16*)(ws + WS_H);
    const float* x_in = args.in[I_X];

    if (IN(0)) {
#if (PROBE_MASK >> 0) & 1
        { p0_prologue(F, args); }
        GRID_BAR();
#endif
        { p0_prologue(F, args); }
    } SEAM(0);
    if (IN(1)) {
#if (PROBE_MASK >> 1) & 1
        { norm_phase(F, x_in, args.in[I_NORMG] + 0 * D, mod + 0 * D, mod + 1 * D, H); }
        GRID_BAR();
#endif
        { norm_phase(F, x_in, args.in[I_NORMG] + 0 * D, mod + 0 * D, mod + 1 * D, H); }
    } SEAM(1);
    if (IN(2)) {
#if (PROBE_MASK >> 2) & 1
        { pg8::Gemm g{H, (const bf16*)(ws + WS_WS5IN), M, D, D}; pg8::StaticOrder S; S.init(M, D, F.G, (int)blockIdx.x);
        pg8::EpiS5U E{(bf16*)(ws + WS_UG)}; pg8::gemm_phase<pg8::EpiS5U, pg8::StaticOrder, true, true>(F.lds, g, S, E); }
        GRID_BAR();
#endif
        { pg8::Gemm g{H, (const bf16*)(ws + WS_WS5IN), M, D, D}; pg8::StaticOrder S; S.init(M, D, F.G, (int)blockIdx.x);
        pg8::EpiS5U E{(bf16*)(ws + WS_UG)}; pg8::gemm_phase<pg8::EpiS5U, pg8::StaticOrder, true, true>(F.lds, g, S, E); }
    } SEAM(2);
    if (IN(3)) {
#if (PROBE_MASK >> 3) & 1
        { for (int it = F.vcu; it < BATCH * S5G; it += F.G) s5_item(F, args, it); }
        GRID_BAR();
#endif
        { for (int it = F.vcu; it < BATCH * S5G; it += F.G) s5_item(F, args, it); }
    } SEAM(3);
    if (IN(4)) {
#if (PROBE_MASK >> 4) & 1
        { pg8::Gemm g{(const bf16*)(ws + WS_Y), (const bf16*)(ws + WS_WGLU), M, 2 * D, D}; pg8::StaticOrder S; S.init(M, 2 * D, F.G, (int)blockIdx.x);
        pg8::EpiGluRes E{x_in, X, mod + 2 * D}; pg8::gemm_phase<pg8::EpiGluRes, pg8::StaticOrder, true, true>(F.lds, g, S, E); }
        GRID_BAR();
#endif
        { pg8::Gemm g{(const bf16*)(ws + WS_Y), (const bf16*)(ws + WS_WGLU), M, 2 * D, D}; pg8::StaticOrder S; S.init(M, 2 * D, F.G, (int)blockIdx.x);
        pg8::EpiGluRes E{x_in, X, mod + 2 * D}; pg8::gemm_phase<pg8::EpiGluRes, pg8::StaticOrder, true, true>(F.lds, g, S, E); }
    } SEAM(4);
    if (IN(5)) {
#if (PROBE_MASK >> 5) & 1
        { norm_phase(F, X, args.in[I_NORMG] + 1 * D, mod + 3 * D, mod + 4 * D, H); }
        GRID_BAR();
#endif
        { norm_phase(F, X, args.in[I_NORMG] + 1 * D, mod + 3 * D, mod + 4 * D, H); }
    } SEAM(5);
    if (IN(6)) {
#if (PROBE_MASK >> 6) & 1
        { pg8::Gemm g{H, (const bf16*)(ws + WS_WGU0), M, 2 * FFH, D}; pg8::StaticOrder S; S.init(M, 2 * FFH, F.G, (int)blockIdx.x);
        pg8::EpiSwiGlu E{(bf16*)(ws + WS_HID), FFH}; pg8::gemm_phase<pg8::EpiSwiGlu, pg8::StaticOrder, true, true>(F.lds, g, S, E); }
        GRID_BAR();
#endif
        { pg8::Gemm g{H, (const bf16*)(ws + WS_WGU0), M, 2 * FFH, D}; pg8::StaticOrder S; S.init(M, 2 * FFH, F.G, (int)blockIdx.x);
        pg8::EpiSwiGlu E{(bf16*)(ws + WS_HID), FFH}; pg8::gemm_phase<pg8::EpiSwiGlu, pg8::StaticOrder, true, true>(F.lds, g, S, E); }
    } SEAM(6);
    if (IN(7)) {
#if (PROBE_MASK >> 7) & 1
        { pg8::Gemm g{(const bf16*)(ws + WS_HID), (const bf16*)(ws + WS_WDN0), M, D, FFH}; pg8::StaticOrder S; S.init(M, D, F.G, (int)blockIdx.x);
        pg8::EpiRes E{X, XD, mod + 5 * D}; pg8::gemm_phase<pg8::EpiRes, pg8::StaticOrder, true, true>(F.lds, g, S, E); }
        GRID_BAR();
#endif
        { pg8::Gemm g{(const bf16*)(ws + WS_HID), (const bf16*)(ws + WS_WDN0), M, D, FFH}; pg8::StaticOrder S; S.init(M, D, F.G, (int)blockIdx.x);
        pg8::EpiRes E{X, X, mod + 5 * D}; pg8::gemm_phase<pg8::EpiRes, pg8::StaticOrder, true, true>(F.lds, g, S, E); }
    } SEAM(7);
    const float* mod1 = mod + 4 * NMOD;
    if (IN(8)) {
#if (PROBE_MASK >> 8) & 1
        { norm_phase(F, X, args.in[I_NORMG] + 2 * D, mod1 + 0 * D, mod1 + 1 * D, H); }
        GRID_BAR();
#endif
        { norm_phase(F, X, args.in[I_NORMG] + 2 * D, mod1 + 0 * D, mod1 + 1 * D, H); }
    } SEAM(8);
    if (IN(9)) {
#if (PROBE_MASK >> 9) & 1
        { pg8::Gemm g{H, (const bf16*)(ws + WS_WLIN), M, 2 * LRUW, D}; pg8::StaticOrder S; S.init(M, 2 * LRUW, F.G, (int)blockIdx.x);
        pg8::EpiLruIn E{(bf16*)(ws + WS_GG), (bf16*)(ws + WS_XB)}; pg8::gemm_phase<pg8::EpiLruIn, pg8::StaticOrder, true, true>(F.lds, g, S, E); }
        GRID_BAR();
#endif
        { pg8::Gemm g{H, (const bf16*)(ws + WS_WLIN), M, 2 * LRUW, D}; pg8::StaticOrder S; S.init(M, 2 * LRUW, F.G, (int)blockIdx.x);
        pg8::EpiLruIn E{(bf16*)(ws + WS_GG), (bf16*)(ws + WS_XB)}; pg8::gemm_phase<pg8::EpiLruIn, pg8::StaticOrder, true, true>(F.lds, g, S, E); }
    } SEAM(9);
#ifdef PROBE_LRUA
    if (IN(10)) { lruA_phase(F, args); GRID_BAR(); }
#endif
    if (IN(10)) { lruA_phase(F, args); } SEAM(10);
    if (IN(11)) {
#if (PROBE_MASK >> 11) & 1
        { lruB_phase(F, args); }
        GRID_BAR();
#endif
        { lruB_phase(F, args); }
    } SEAM(11);
    if (IN(12)) {
#if (PROBE_MASK >> 12) & 1
        { pg8::Gemm g{(const bf16*)(ws + WS_YL), (const bf16*)(ws + WS_WLOUT), M, D, LRUW}; pg8::StaticOrder S; S.init(M, D, F.G, (int)blockIdx.x);
        pg8::EpiRes E{X, XD, mod1 + 2 * D}; pg8::gemm_phase<pg8::EpiRes, pg8::StaticOrder, true, true>(F.lds, g, S, E); }
        GRID_BAR();
#endif
        { pg8::Gemm g{(const bf16*)(ws + WS_YL), (const bf16*)(ws + WS_WLOUT), M, D, LRUW}; pg8::StaticOrder S; S.init(M, D, F.G, (int)blockIdx.x);
        pg8::EpiRes E{X, X, mod1 + 2 * D}; pg8::gemm_phase<pg8::EpiRes, pg8::StaticOrder, true, true>(F.lds, g, S, E); }
    } SEAM(12);
    if (IN(13)) {
#if (PROBE_MASK >> 13) & 1
        { norm_phase(F, X, args.in[I_NORMG] + 3 * D, mod1 + 3 * D, mod1 + 4 * D, H); }
        GRID_BAR();
#endif
        { norm_phase(F, X, args.in[I_NORMG] + 3 * D, mod1 + 3 * D, mod1 + 4 * D, H); }
    } SEAM(13);
    if (IN(14)) {
#if (PROBE_MASK >> 14) & 1
        { pg8::Gemm g{H, (const bf16*)(ws + WS_WGU1), M, 2 * FFH, D}; pg8::StaticOrder S; S.init(M, 2 * FFH, F.G, (int)blockIdx.x);
        pg8::EpiSwiGlu E{(bf16*)(ws + WS_HID), FFH}; pg8::gemm_phase<pg8::EpiSwiGlu, pg8::StaticOrder, true, true>(F.lds, g, S, E); }
        GRID_BAR();
#endif
        { pg8::Gemm g{H, (const bf16*)(ws + WS_WGU1), M, 2 * FFH, D}; pg8::StaticOrder S; S.init(M, 2 * FFH, F.G, (int)blockIdx.x);
        pg8::EpiSwiGlu E{(bf16*)(ws + WS_HID), FFH}; pg8::gemm_phase<pg8::EpiSwiGlu, pg8::StaticOrder, true, true>(F.lds, g, S, E); }
    } SEAM(14);
    if (IN(15)) {
#if (PROBE_MASK >> 15) & 1
        { pg8::Gemm g{(const bf16*)(ws + WS_HID), (const bf16*)(ws + WS_WDN1), M, D, FFH}; pg8::StaticOrder S; S.init(M, D, F.G, (int)blockIdx.x);
        pg8::EpiRes E{X, XD, mod1 + 5 * D}; pg8::gemm_phase<pg8::EpiRes, pg8::StaticOrder, true, true>(F.lds, g, S, E); }
        GRID_BAR();
#endif
        { pg8::Gemm g{(const bf16*)(ws + WS_HID), (const bf16*)(ws + WS_WDN1), M, D, FFH}; pg8::StaticOrder S; S.init(M, D, F.G, (int)blockIdx.x);
        pg8::EpiRes E{X, X, mod1 + 5 * D}; pg8::gemm_phase<pg8::EpiRes, pg8::StaticOrder, true, true>(F.lds, g, S, E); }
    } SEAM(15);
    if (IN(16)) { final_norm_phase(F, X, args.in[I_FINALG], args.out); }
#undef IN
#undef SEAM
}

extern "C" void kernel_launch(void* const* d_in, const int* in_sizes, int n_in, void* d_out, int out_size, void* d_ws, size_t ws_size, hipStream_t stream) {
    static int grid = 0;
    if (grid == 0) {
        if (n_in != 27 || out_size != M * D || ws_size < WS_END) { fprintf(stderr, "kernel_launch: unexpected shapes (n_in %d out %d ws %zu)\n", n_in, out_size, ws_size); grid = -1; return; }
        int dev = 0, cus = 0, per_cu = 0;
        if (hipGetDevice(&dev) != hipSuccess || hipDeviceGetAttribute(&cus, hipDeviceAttributeMultiprocessorCount, dev) != hipSuccess) { grid = -1; return; }
        if (hipFuncSetAttribute((const void*)fwd_kernel, hipFuncAttributeMaxDynamicSharedMemorySize, LDS_BYTES) != hipSuccess) { fprintf(stderr, "kernel_launch: hipFuncSetAttribute failed\n"); grid = -1; return; }
        if (hipOccupancyMaxActiveBlocksPerMultiprocessor(&per_cu, (const void*)fwd_kernel, NTHREADS, LDS_BYTES) != hipSuccess || per_cu < 1) { fprintf(stderr, "kernel_launch: occupancy query says %d\n", per_cu); per_cu = 1; }
        (void)hipGetLastError();
        grid = cus;
        if (grid > 256) grid = 256;
        fprintf(stderr, "kernel_launch: grid %d (cus %d, per_cu %d)\n", grid, cus, per_cu);
    }
    if (grid < 0) return;
#if 1
    if (hipMemsetAsync((char*)d_ws + WS_CTL, 0, CTL_ZERO_BYTES, stream) != hipSuccess) { fprintf(stderr, "kernel_launch: memset failed\n"); return; }
#endif
    Args a{};
    for (int i = 0; i < 27; ++i) a.in[i] = (const float*)d_in[i];
    a.out = (float*)d_out; a.ws = (unsigned char*)d_ws;
#if MK_N_LAUNCHES == 1
    a.ph_lo = 0; a.ph_hi = NPHASES;
    void* kargs[] = {&a};
    hipError_t e = hipLaunchCooperativeKernel((const void*)fwd_kernel, dim3(grid), dim3(NTHREADS), kargs, LDS_BYTES, stream);
    if (e != hipSuccess) fprintf(stderr, "kernel_launch: cooperative launch failed: %s\n", hipGetErrorString(e));
#else
    for (int ph = 0; ph < NPHASES; ++ph) { a.ph_lo = ph; a.ph_hi = ph + 1;
        hipLaunchKernelGGL(fwd_kernel, dim3(grid), dim3(NTHREADS), LDS_BYTES, stream, a);
        const hipError_t le = hipPeekAtLastError(); if (le != hipSuccess) { fprintf(stderr, "kernel_launch: launch %d failed: %s\n", ph, hipGetErrorName(le)); break; } }
#endif
}
```

```cpp
#include <hip/hip_runtime.h>
#include <hip/hip_cooperative_groups.h>
#include <cstdio>
#include <cstdint>
#define MK_N_LAUNCHES 1
namespace pg8 {
#define PG8_LAS __attribute__((address_space(3)))
typedef unsigned short bf16_t;
typedef short bf16x8 __attribute__((ext_vector_type(8)));
typedef float f32x4 __attribute__((ext_vector_type(4)));
typedef unsigned u32x4 __attribute__((ext_vector_type(4)));
constexpr int BM = 256, BK = 64, HALF = 128, HTB = HALF * BK * 2  , STAGE_BYTES = 8 * HTB, NXCD = 8, WGM = 8;

__host__ __device__ __forceinline__ int lds_byte(int r, int c) { const int st = (r >> 4) * 2 + (c >> 5), rr = r & 15, cc = c & 31, ob = rr * 64 + cc * 2; return st * 1024 + (ob ^ (((ob >> 9) & 1) << 5)); }
__host__ __device__ __forceinline__ void stage_rc(int b, int& R, int& C) { const int st = b / 1024, sb = b % 1024, swz = sb ^ (((sb >> 9) & 1) << 5); R = (st >> 1) * 16 + swz / 64; C = (st & 1) * 32 + (swz % 64) / 2; }
__host__ __device__ __forceinline__ int perm32(int rho) { const int n = rho >> 4, i = rho & 15; return 8 * (i >> 2) + 4 * n + (i & 3); }

struct Unit { int pm, pn; };
struct Gemm { const bf16_t* A; const bf16_t* Bt; int M, N, K; };

struct StaticOrder {
    int nM, nN, nwg, G, c;
    __host__ __device__ void init(int M, int N, int G_, int c_) { nM = M / BM; nN = N / BM; nwg = nM * nN; G = G_; c = c_; }
    __host__ __device__ bool next(int i, Unit& u) const {
        const long L = (long)i * G + c; if (L >= nwg) return false;
        int wgid = (int)L; { const int q = nwg / NXCD, r = nwg % NXCD, xcd = wgid % NXCD, off = wgid / NXCD; wgid = (xcd < r ? xcd * (q + 1) : r * (q + 1) + (xcd - r) * q) + off; }
        const int nig = WGM * nN, gid = wgid / nig, fm = gid * WGM, gsz = (nM - fm) < WGM ? (nM - fm) : WGM;
        u.pm = fm + ((wgid % nig) % gsz); u.pn = (wgid % nig) / gsz; return true;
    }
    __device__ __forceinline__ void a_ready(const Unit&) const {}
    __device__ __forceinline__ void done(const Unit&) const {}
};
__device__ __forceinline__ unsigned cvt_pk_bf16(float lo, float hi) { unsigned r; asm volatile("v_cvt_pk_bf16_f32 %0, %1, %2" : "=v"(r) : "v"(lo), "v"(hi)); return r; }
typedef float f32x2 __attribute__((ext_vector_type(2)));
__device__ __forceinline__ float sigmoidf_(float x) { return __builtin_amdgcn_rcpf(1.0f + __expf(-x)); }
__device__ __forceinline__ float gelu_tanh(float x) { const float u = 1.5957691216057308f * (x + 0.044715f * x * x * x); return x * sigmoidf_(u); }
constexpr int SEQ_SHIFT = 11;
constexpr int NMODP = 12288;

struct EpiS5U {
    static constexpr bool PERM = true, AFTER_DRAIN = false;
    bf16_t* UG;
    __device__ __forceinline__ void operator()(const f32x4 (&acc)[2][2][4][2], const Unit& u, int wr, int wc, int fr, int fq) const {
        const int row0 = u.pm * BM + wr * 64 + fr, colb = u.pn * BM + wc * 32 + 8 * fq;
#pragma unroll
        for (int ai = 0; ai < 2; ++ai)
#pragma unroll
            for (int m = 0; m < 4; ++m) { const int r = row0 + ai * HALF + m * 16, b = r >> SEQ_SHIFT, t = r & 2047;
#pragma unroll
                for (int bj = 0; bj < 2; ++bj) { const int c0 = colb + bj * HALF, g = c0 >> 4, hf = (c0 >> 3) & 1;
                    const f32x4 v0 = acc[ai][bj][m][0], v1 = acc[ai][bj][m][1];
                    u32x4 w; w.x = cvt_pk_bf16(v0[0], v0[1]); w.y = cvt_pk_bf16(v0[2], v0[3]); w.z = cvt_pk_bf16(v1[0], v1[1]); w.w = cvt_pk_bf16(v1[2], v1[3]);
                    *(u32x4*)(UG + ((size_t)(b * 128 + g) * 2048 + t) * 16 + 8 * hf) = w; } }
    }
};
struct EpiGluRes {
    static constexpr bool PERM = false, AFTER_DRAIN = false;
    const float* xin; float* xout; const float* gate;
    __device__ __forceinline__ void operator()(const f32x4 (&acc)[2][2][4][2], const Unit& u, int wr, int wc, int fr, int fq) const {
        const int row0 = u.pm * BM + wr * 64 + fr, j0 = u.pn * HALF + wc * 32 + 4 * fq;
#pragma unroll
        for (int ai = 0; ai < 2; ++ai)
#pragma unroll
            for (int m = 0; m < 4; ++m) { const int r = row0 + ai * HALF + m * 16, b = r >> SEQ_SHIFT;
#pragma unroll
                for (int n = 0; n < 2; ++n) { const int j = j0 + 16 * n;
                    const f32x4 xv = *(const f32x4*)(xin + (size_t)r * 2048 + j), gv = *(const f32x4*)(gate + b * NMODP + j);
                    const f32x4 va = acc[ai][0][m][n], gt = acc[ai][1][m][n]; f32x4 o;
#pragma unroll
                    for (int i = 0; i < 4; ++i) o[i] = xv[i] + gv[i] * (va[i] * sigmoidf_(gt[i]));
                    *(f32x4*)(xout + (size_t)r * 2048 + j) = o; } }
    }
};
struct EpiSwiGlu {
    static constexpr bool PERM = true, AFTER_DRAIN = false;
    bf16_t* O; int ldc;
    __device__ __forceinline__ void operator()(const f32x4 (&acc)[2][2][4][2], const Unit& u, int wr, int wc, int fr, int fq) const {
        const int row0 = u.pm * BM + wr * 64 + fr, j0 = u.pn * HALF + wc * 32 + 8 * fq;
#pragma unroll
        for (int ai = 0; ai < 2; ++ai)
#pragma unroll
            for (int m = 0; m < 4; ++m) { const int r = row0 + ai * HALF + m * 16; float o[8];
#pragma unroll
                for (int n = 0; n < 2; ++n) { const f32x4 g = acc[ai][0][m][n], uu = acc[ai][1][m][n];
#pragma unroll
                    for (int i = 0; i < 4; ++i) o[4 * n + i] = g[i] * sigmoidf_(g[i]) * uu[i]; }
                u32x4 w; w.x = cvt_pk_bf16(o[0], o[1]); w.y = cvt_pk_bf16(o[2], o[3]); w.z = cvt_pk_bf16(o[4], o[5]); w.w = cvt_pk_bf16(o[6], o[7]);
                *(u32x4*)(O + (size_t)r * ldc + j0) = w; }
    }
};
struct EpiRes {
    static constexpr bool PERM = false, AFTER_DRAIN = false;
    const float* xin; float* xout; const float* gate;
    __device__ __forceinline__ void operator()(const f32x4 (&acc)[2][2][4][2], const Unit& u, int wr, int wc, int fr, int fq) const {
        const int row0 = u.pm * BM + wr * 64 + fr, col0 = u.pn * BM + wc * 32 + 4 * fq;
#pragma unroll
        for (int ai = 0; ai < 2; ++ai)
#pragma unroll
            for (int m = 0; m < 4; ++m) { const int r = row0 + ai * HALF + m * 16, b = r >> SEQ_SHIFT;
#pragma unroll
                for (int bj = 0; bj < 2; ++bj)
#pragma unroll
                    for (int n = 0; n < 2; ++n) { const int c = col0 + bj * HALF + n * 16;
                        const f32x4 xv = *(const f32x4*)(xin + (size_t)r * 2048 + c), gv = *(const f32x4*)(gate + b * NMODP + c);
                        *(f32x4*)(xout + (size_t)r * 2048 + c) = xv + gv * acc[ai][bj][m][n]; } }
    }
};
struct EpiLruIn {
    static constexpr bool PERM = true, AFTER_DRAIN = false;
    bf16_t* GG; bf16_t* XB;
    __device__ __forceinline__ void operator()(const f32x4 (&acc)[2][2][4][2], const Unit& u, int wr, int wc, int fr, int fq) const {
        const int row0 = u.pm * BM + wr * 64 + fr; const bool isg = u.pn < 11;
        const int colb = (isg ? u.pn : u.pn - 11) * BM + wc * 32 + 8 * fq; bf16_t* base = isg ? GG : XB;
#pragma unroll
        for (int ai = 0; ai < 2; ++ai)
#pragma unroll
            for (int m = 0; m < 4; ++m) { bf16_t* rowp = base + (size_t)(row0 + ai * HALF + m * 16) * 2816 + colb;
#pragma unroll
                for (int bj = 0; bj < 2; ++bj) { f32x4 v0 = acc[ai][bj][m][0], v1 = acc[ai][bj][m][1];
                    if (isg) {
#pragma unroll
                        for (int i = 0; i < 4; ++i) { v0[i] = gelu_tanh(v0[i]); v1[i] = gelu_tanh(v1[i]); } }
                    u32x4 w; w.x = cvt_pk_bf16(v0[0], v0[1]); w.y = cvt_pk_bf16(v0[2], v0[3]); w.z = cvt_pk_bf16(v1[0], v1[1]); w.w = cvt_pk_bf16(v1[2], v1[3]);
                    *(u32x4*)(rowp + bj * HALF) = w; } }
    }
};
template <class Epi, class Sched, bool ALIGN_EPI = false, bool SP2 = false>
__device__ __forceinline__ void gemm_phase(PG8_LAS unsigned char* lds, const Gemm g, const Sched& S, const Epi& E) {
    const int tid = threadIdx.x, wid = __builtin_amdgcn_readfirstlane(tid >> 6), lane = tid & 63, wr = wid >> 2, wc = wid & 3, fr = lane & 15, fq = lane >> 4;
    const int K = g.K, nt = K / BK;
    unsigned voffA[2], voffB[2];
#pragma unroll
    for (int i = 0; i < 2; ++i) { int R, C; stage_rc(tid * 16 + i * 8192, R, C); const int Rb = Epi::PERM ? ((R & ~31) + perm32(R & 31)) : R;
        voffA[i] = (unsigned)(R * K + C) * 2u; voffB[i] = (unsigned)(Rb * K + C) * 2u; }
    const size_t kstep = (size_t)(BK * 2);
    const size_t hstep = (size_t)HALF * K * 2;
    const size_t tstep = 2 * hstep;
    const unsigned ldsw = (unsigned)wid * 1024u;
    const int aoff = lds_byte(wr * 64 + fr, fq * 8), boff = lds_byte(wc * 32 + fr, fq * 8);
#define PG8_SA(b, h) (((b) * 2 + (h)) * HTB)
#define PG8_SB(b, h) ((4 + (b) * 2 + (h)) * HTB)
#define PG8_STAGE(bufoff, gbase, voff) do { _Pragma("unroll") for (int _i = 0; _i < 2; ++_i) \
        __builtin_amdgcn_global_load_lds((const unsigned*)((const char*)(gbase) + (voff)[_i]), (PG8_LAS unsigned*)(lds + (bufoff) + ldsw + _i * 8192), 16, 0, 0); } while (0)
#define PG8_LDA(dst, b, h) do { _Pragma("unroll") for (int m = 0; m < 4; ++m) _Pragma("unroll") for (int k = 0; k < 2; ++k) dst[m][k] = *(const PG8_LAS bf16x8*)(lds + PG8_SA(b, h) + aoff + m * 2048 + k * 1024); } while (0)
#define PG8_LDB(dst, b, h) do { _Pragma("unroll") for (int n = 0; n < 2; ++n) _Pragma("unroll") for (int k = 0; k < 2; ++k) dst[n][k] = *(const PG8_LAS bf16x8*)(lds + PG8_SB(b, h) + boff + n * 2048 + k * 1024); } while (0)
#define PG8_MMA(ai, bj, At, Bt) do { __builtin_amdgcn_s_setprio(1); _Pragma("unroll") for (int m = 0; m < 4; ++m) _Pragma("unroll") for (int n = 0; n < 2; ++n) _Pragma("unroll") for (int k = 0; k < 2; ++k) \
        acc[ai][bj][m][n] = __builtin_amdgcn_mfma_f32_16x16x32_bf16(Bt[n][k], At[m][k], acc[ai][bj][m][n], 0, 0, 0); __builtin_amdgcn_s_setprio(0); } while (0)
#define PG8_WAIT_V(n) asm volatile("s_waitcnt vmcnt(" #n ")" ::: "memory")
#define PG8_WAIT_L(n) asm volatile("s_waitcnt lgkmcnt(" #n ")" ::: "memory")
#define PG8_BAR __builtin_amdgcn_s_barrier()
#define PG8_SCHED __builtin_amdgcn_sched_barrier(0)
    Unit cur, nxt; int ui = 0;
    if (!S.next(0, cur)) return;
    f32x4 acc[2][2][4][2];
#pragma unroll
    for (int a = 0; a < 2; ++a)
#pragma unroll
        for (int b = 0; b < 2; ++b)
#pragma unroll
            for (int m = 0; m < 4; ++m)
#pragma unroll
                for (int n = 0; n < 2; ++n) acc[a][b][m][n] = (f32x4){0.f, 0.f, 0.f, 0.f};
    bf16x8 At[4][2], B0[2][2], B1[2][2];
    const char* cA = (const char*)g.A + (size_t)cur.pm * tstep; const char* cB = (const char*)g.Bt + (size_t)cur.pn * tstep;
    S.a_ready(cur);
    if constexpr (SP2) {
        PG8_STAGE(PG8_SB(0, 0), cB, voffB); PG8_STAGE(PG8_SB(0, 1), cB + hstep, voffB); PG8_STAGE(PG8_SA(0, 0), cA, voffA); PG8_STAGE(PG8_SA(0, 1), cA + hstep, voffA);
        if (wr == 1) PG8_BAR;
        PG8_WAIT_V(2); PG8_BAR;
        PG8_STAGE(PG8_SB(1, 0), cB + kstep, voffB); PG8_STAGE(PG8_SA(1, 0), cA + kstep, voffA); PG8_STAGE(PG8_SB(1, 1), cB + hstep + kstep, voffB);
        PG8_WAIT_V(6); PG8_BAR;
    } else {
        PG8_STAGE(PG8_SB(0, 0), cB, voffB); PG8_STAGE(PG8_SA(0, 0), cA, voffA); PG8_STAGE(PG8_SB(0, 1), cB + hstep, voffB); PG8_STAGE(PG8_SA(0, 1), cA + hstep, voffA);
        if (wr == 1) PG8_BAR;
        PG8_WAIT_V(4); PG8_BAR;
        PG8_STAGE(PG8_SB(1, 0), cB + kstep, voffB); PG8_STAGE(PG8_SA(1, 0), cA + kstep, voffA); PG8_STAGE(PG8_SB(1, 1), cB + hstep + kstep, voffB);
        PG8_WAIT_V(6); PG8_BAR;
    }
    for (;;) {
        const bool has_next = S.next(ui + 1, nxt);
        const char* nA = has_next ? (const char*)g.A + (size_t)nxt.pm * tstep : cA; const char* nB = has_next ? (const char*)g.Bt + (size_t)nxt.pn * tstep : cB;
        for (int t = 0; t < nt; t += 2) {
            const bool last = (t == nt - 2);
            const char* a1 = cA + (size_t)(t + 1) * kstep;
            const char* a2 = last ? nA : cA + (size_t)(t + 2) * kstep; const char* b2 = last ? nB : cB + (size_t)(t + 2) * kstep;
            const char* a3 = a2 + kstep; const char* b3 = b2 + kstep;
            if (last && has_next) S.a_ready(nxt);
            if constexpr (SP2) {
            PG8_LDB(B0, 0, 0); PG8_LDB(B1, 0, 1); PG8_SCHED; PG8_LDA(At, 0, 0); PG8_STAGE(PG8_SA(1, 1), a1 + hstep, voffA);
            PG8_WAIT_V(8); PG8_WAIT_L(0); PG8_BAR; PG8_MMA(0, 0, At, B0); PG8_MMA(0, 1, At, B1); PG8_BAR; PG8_SCHED;
            PG8_LDA(At, 0, 1); PG8_STAGE(PG8_SB(0, 0), b2, voffB); PG8_STAGE(PG8_SB(0, 1), b2 + hstep, voffB); PG8_STAGE(PG8_SA(0, 0), a2, voffA);
            PG8_WAIT_V(8); PG8_WAIT_L(0); PG8_BAR; PG8_MMA(1, 0, At, B0); PG8_MMA(1, 1, At, B1); PG8_BAR; PG8_SCHED;
            PG8_LDB(B0, 1, 0); PG8_LDB(B1, 1, 1); PG8_SCHED; PG8_LDA(At, 1, 0); PG8_STAGE(PG8_SA(0, 1), a2 + hstep, voffA);
            PG8_WAIT_V(8); PG8_WAIT_L(0); PG8_BAR; PG8_MMA(0, 0, At, B0); PG8_MMA(0, 1, At, B1); PG8_BAR; PG8_SCHED;
            PG8_LDA(At, 1, 1); PG8_STAGE(PG8_SB(1, 0), b3, voffB); PG8_STAGE(PG8_SB(1, 1), b3 + hstep, voffB); PG8_STAGE(PG8_SA(1, 0), a3, voffA);
            PG8_WAIT_V(8); PG8_WAIT_L(0); PG8_BAR; PG8_MMA(1, 0, At, B0); PG8_MMA(1, 1, At, B1); PG8_BAR; PG8_SCHED;
            } else {
            PG8_LDB(B0, 0, 0); PG8_SCHED; PG8_LDA(At, 0, 0); PG8_STAGE(PG8_SA(1, 1), a1 + hstep, voffA);
            PG8_WAIT_L(8); PG8_BAR; PG8_WAIT_L(0); PG8_MMA(0, 0, At, B0); PG8_BAR; PG8_SCHED;
            PG8_LDB(B1, 0, 1); PG8_STAGE(PG8_SB(0, 0), b2, voffB);
            PG8_BAR; PG8_WAIT_L(0); PG8_MMA(0, 1, At, B1); PG8_BAR;
            PG8_LDA(At, 0, 1); PG8_STAGE(PG8_SA(0, 0), a2, voffA);
            PG8_BAR; PG8_WAIT_L(0); PG8_MMA(1, 0, At, B0); PG8_BAR; PG8_SCHED;
            PG8_STAGE(PG8_SB(0, 1), b2 + hstep, voffB);
            PG8_WAIT_V(6); PG8_BAR; PG8_MMA(1, 1, At, B1); PG8_BAR;
            PG8_LDB(B0, 1, 0); PG8_SCHED; PG8_LDA(At, 1, 0); PG8_STAGE(PG8_SA(0, 1), a2 + hstep, voffA);
            PG8_WAIT_L(8); PG8_BAR; PG8_WAIT_L(0); PG8_MMA(0, 0, At, B0); PG8_BAR; PG8_SCHED;
            PG8_LDB(B1, 1, 1); PG8_STAGE(PG8_SB(1, 0), b3, voffB);
            PG8_BAR; PG8_WAIT_L(0); PG8_MMA(0, 1, At, B1); PG8_BAR;
            PG8_LDA(At, 1, 1); PG8_STAGE(PG8_SA(1, 0), a3, voffA);
            PG8_BAR; PG8_WAIT_L(0); PG8_MMA(1, 0, At, B0); PG8_BAR; PG8_SCHED;
            PG8_STAGE(PG8_SB(1, 1), b3 + hstep, voffB);
            PG8_WAIT_V(6); PG8_BAR; PG8_MMA(1, 1, At, B1); PG8_BAR;
            }
        }
        if constexpr (ALIGN_EPI) { if (wr == 0) PG8_BAR; }
        if constexpr (!Epi::AFTER_DRAIN) { E(acc, cur, wr, wc, fr, fq); S.done(cur); }
        if (!has_next) break;
#pragma unroll
        for (int a = 0; a < 2; ++a)
#pragma unroll
            for (int b = 0; b < 2; ++b)
#pragma unroll
                for (int m = 0; m < 4; ++m)
#pragma unroll
                    for (int n = 0; n < 2; ++n) acc[a][b][m][n] = (f32x4){0.f, 0.f, 0.f, 0.f};
        cur = nxt; cA = nA; cB = nB; ++ui;
        if constexpr (ALIGN_EPI) { if (wr == 1) PG8_BAR; }
    }
    PG8_WAIT_V(0);
    if constexpr (!ALIGN_EPI) { if (wr == 0) PG8_BAR; }
    PG8_BAR;
    if constexpr (Epi::AFTER_DRAIN) { E.fused(acc, cur, wr, wc, fr, fq, lds, wid, lane); S.done(cur); }
#undef PG8_SA
#undef PG8_SB
#undef PG8_STAGE
#undef PG8_LDA
#undef PG8_LDB
#undef PG8_MMA
#undef PG8_WAIT_V
#undef PG8_WAIT_L
#undef PG8_BAR
#undef PG8_SCHED
}
}
namespace cg = cooperative_groups;
constexpr int NWAVES = 8, NTHREADS = 512;
#ifndef MK_N_LAUNCHES
#define MK_N_LAUNCHES 1
#endif
constexpr int NPHASES = 17;
constexpr int D = 2048, BATCH = 4, SEQ = 2048, M = BATCH * SEQ, NMOD = 6 * D;
constexpr int S5G = 128, S5P = 64, LRUW = 2816, LRUB = 176, FFH = 5632;
constexpr float EPS = 1e-6f;
constexpr size_t MiB = 1u << 20;
constexpr size_t WS_CTL = 0, CTL_ZERO_BYTES = 64 * 1024;
constexpr size_t WS_MOD = 1 * MiB;
constexpr size_t WS_AT = 1 * MiB + 512 * 1024;
constexpr size_t WS_BT1 = 2 * MiB;
constexpr size_t WS_BT2 = 6 * MiB;
constexpr size_t WS_WGATE = 14 * MiB;
constexpr size_t WS_WS5IN = 20 * MiB, WS_WGLU = 28 * MiB, WS_WGU0 = 44 * MiB, WS_WGU1 = 88 * MiB, WS_WDN0 = 132 * MiB, WS_WDN1 = 154 * MiB, WS_WLIN = 176 * MiB, WS_WLOUT = 198 * MiB;
constexpr size_t WS_X = 210 * MiB, WS_H = 274 * MiB, WS_SCR = 306 * MiB;
constexpr size_t WS_UG = WS_SCR, WS_Y = WS_SCR + 32 * MiB;
constexpr size_t WS_HID = WS_SCR;
constexpr size_t WS_GG = WS_SCR, WS_XB = WS_SCR + 44 * MiB, WS_P = WS_SCR + 88 * MiB, WS_Q = WS_SCR + 132 * MiB, WS_YL = WS_XB;
constexpr size_t WS_TOTG = 16 * MiB + 512 * 1024;
constexpr size_t WS_DUMMY = WS_SCR + 176 * MiB;
constexpr size_t WS_END = WS_SCR + 176 * MiB + 64 * MiB;
constexpr int LDS_BYTES = 163840, MISC_OFF = LDS_BYTES - 256;
constexpr int CW_BAR = 1024, CW_Q0 = 64;
#ifndef USE_CG_SYNC
#define USE_CG_SYNC 0
#endif

#define GAS __attribute__((address_space(1)))
#define LAS __attribute__((address_space(3)))
typedef unsigned short bf16;
typedef unsigned v4u __attribute__((ext_vector_type(4)));
typedef unsigned v2u __attribute__((ext_vector_type(2)));
typedef float f32x4 __attribute__((ext_vector_type(4)));
typedef float f32x2 __attribute__((ext_vector_type(2)));
typedef short bf16x8 __attribute__((ext_vector_type(8)));
#define LDS_WAIT() asm volatile("s_waitcnt lgkmcnt(0)" ::: "memory")
#define LDS_BARRIER() do { asm volatile("s_waitcnt lgkmcnt(0)" ::: "memory"); __builtin_amdgcn_s_barrier(); asm volatile("" ::: "memory"); } while (0)
__device__ __forceinline__ unsigned f2bf(float f) { unsigned u = __builtin_bit_cast(unsigned, f); return (u + 0x7fffu + ((u >> 16) & 1u)) >> 16; }
__device__ __forceinline__ unsigned pk2(float lo, float hi) { return f2bf(lo) | (f2bf(hi) << 16); }
__device__ __forceinline__ float bf2f(unsigned short v) { return __builtin_bit_cast(float, (unsigned)v << 16); }
__device__ __forceinline__ float wave_sum(float v) {
#pragma unroll
    for (int o = 1; o < 64; o <<= 1) v += __shfl_xor(v, o);
    return v;
}

struct Args {
    const float* in[27]; float* out; unsigned char* ws; int ph_lo, ph_hi;
};
enum { I_X = 0, I_C, I_NORMG, I_WADA, I_BADA, I_S5WIN, I_S5LRE, I_S5LIM, I_S5LDT, I_S5BRE, I_S5BIM, I_S5CRE, I_S5CIM, I_S5D, I_S5WGLU,
       I_LWIN, I_LCW, I_LCB, I_LWRG, I_LBRG, I_LWIG, I_LBIG, I_LLAM, I_LWOUT, I_FGU, I_FDN, I_FINALG };

struct Frame {
    LAS unsigned char* lds;
    int tid, lane, wave, vcu, G;
};

template <int MODE> __device__ __forceinline__ int srcmap(int n0, int F) {
    if (MODE == 0) return n0;
    const int pn = n0 >> 8, cl = n0 & 255; return cl < 128 ? 128 * pn + cl : F + 128 * pn + (cl - 128);
}
template <int MODE> __device__ __forceinline__ void p0_transpose_item(const float* W, int K, int N, int F, bf16* WT, LAS float* scr, int item, int lane) {
    const int nblk = N / 32, kb = item / nblk, nb = item % nblk, k0 = 64 * kb, n0 = 32 * nb, s0 = srcmap<MODE>(n0, F);
    float v[32];
    const float* wp = W + (size_t)(k0 + (lane >> 5)) * N + s0 + (lane & 31);
#pragma unroll
    for (int i = 0; i < 32; ++i) v[i] = wp[(size_t)(2 * i) * N];
#pragma unroll
    for (int i = 0; i < 32; ++i) scr[(2 * i + (lane >> 5)) * 33 + (lane & 31)] = v[i];
    LDS_WAIT(); asm volatile("" ::: "memory");
    const int c = lane & 7;
#pragma unroll
    for (int j = 0; j < 4; ++j) { const int n = (lane >> 3) + 8 * j; const LAS float* s = scr + (8 * c) * 33 + n;
        v4u o; o.x = pk2(s[0 * 33], s[1 * 33]); o.y = pk2(s[2 * 33], s[3 * 33]); o.z = pk2(s[4 * 33], s[5 * 33]); o.w = pk2(s[6 * 33], s[7 * 33]);
        *(GAS v4u*)(WT + (size_t)(n0 + n) * K + k0 + 8 * c) = o; }
    LDS_WAIT(); asm volatile("" ::: "memory");
}

__device__ __forceinline__ void p0_mod_item(const Frame& F, const Args& a, int item) {
    LAS float* cond = (LAS float*)F.lds;
    LAS float* red = (LAS float*)(F.lds + 32768);
    const int layer = item / 96, n0 = (item % 96) * 128;
    const float* c = a.in[I_C];
    for (int i = F.tid; i < 4 * D; i += NTHREADS) { const int b = i >> 11, k = i & 2047; const float v = c[i]; cond[k * 4 + b] = v / (1.0f + __expf(-v)); }
    __syncthreads();
    const float* W = a.in[I_WADA] + (size_t)layer * D * NMOD + n0 + 2 * F.lane;
    float acc[4][2] = {};
    const int kbeg = F.wave * 256;
#pragma unroll 16
    for (int k = kbeg; k < kbeg + 256; ++k) {
        const f32x2 w = *(const f32x2*)(W + (size_t)k * NMOD); const f32x4 cv = *(const LAS f32x4*)(cond + k * 4);
#pragma unroll
        for (int b = 0; b < 4; ++b) { acc[b][0] += cv[b] * w.x; acc[b][1] += cv[b] * w.y; }
    }
#pragma unroll
    for (int b = 0; b < 4; ++b) { red[(F.wave * 4 + b) * 128 + 2 * F.lane] = acc[b][0]; red[(F.wave * 4 + b) * 128 + 2 * F.lane + 1] = acc[b][1]; }
    __syncthreads();
    { const int b = F.tid >> 7, n = F.tid & 127; float s = a.in[I_BADA][layer * NMOD + n0 + n];
#pragma unroll
      for (int w = 0; w < 8; ++w) s += red[(w * 4 + b) * 128 + n];
      ((float*)(a.ws + WS_MOD))[(layer * 4 + b) * NMOD + n0 + n] = s; }
    __syncthreads();
}

__device__ __forceinline__ void p0_wgate_item(const Frame& F, const Args& a, int item) {
    const int h = item >> 1, gate = item & 1; bf16* dst = (bf16*)(a.ws + WS_WGATE) + (size_t)item * 176 * 192; const float* W = gate ? a.in[I_LWIG] : a.in[I_LWRG];
    for (int i = F.tid; i < 176 * 192; i += NTHREADS) { const int n = i / 192, k = i % 192; float v = 0.f; if (k < 176) v = W[((size_t)h * 176 + k) * 176 + n]; dst[i] = (bf16)f2bf(v); }
}

__device__ __forceinline__ void p0_s5prep_item(const Frame& F, const Args& a, int g) {
    LAS float* apr = (LAS float*)F.lds;
    LAS float* api = apr + 9 * 64;
    LAS float* bbr = api + 9 * 64;
    LAS float* bbi = bbr + 1024;
    LAS float* ccr = bbi + 1024;
    LAS float* cci = ccr + 1024;
    LAS float* fre = cci + 1024;
    LAS float* fim = fre + 64;
    LAS float* ktab = fim + 64;
    const int tid = F.tid;
    if (tid < 64) { const int p = tid; const float lr = a.in[I_S5LRE][g * 64 + p], li = a.in[I_S5LIM][g * 64 + p], dt = expf(a.in[I_S5LDT][g]);
        const float mag = expf(lr * dt), ang = li * dt, abr = mag * cosf(ang), abi = mag * sinf(ang), nr = abr - 1.0f, ni = abi, den = lr * lr + li * li;
        fre[p] = (nr * lr + ni * li) / den; fim[p] = (ni * lr - nr * li) / den;
        float pr = 1.f, pi = 0.f;
        for (int k = 0; k < 9; ++k) { apr[k * 64 + p] = pr; api[k * 64 + p] = pi; const float t = pr * abr - pi * abi; pi = pr * abi + pi * abr; pr = t; }
        float* at = (float*)(a.ws + WS_AT) + (g * 64 + p) * 2; at[0] = apr[8 * 64 + p]; at[1] = api[8 * 64 + p]; }
    __syncthreads();
    for (int i = tid; i < 1024; i += NTHREADS) { const int p = i >> 4; const float br = a.in[I_S5BRE][(size_t)g * 1024 + i], bi = a.in[I_S5BIM][(size_t)g * 1024 + i];
        bbr[i] = fre[p] * br - fim[p] * bi; bbi[i] = fre[p] * bi + fim[p] * br;
        ccr[i] = a.in[I_S5CRE][(size_t)g * 1024 + i]; cci[i] = a.in[I_S5CIM][(size_t)g * 1024 + i]; }
    __syncthreads();
    for (int i = tid; i < 2048; i += NTHREADS) { const int d = i >> 8, co = (i >> 4) & 15, ci = i & 15; float s = 0.f;
        for (int p = 0; p < 64; ++p) { const float cr = ccr[co * 64 + p], cim = cci[co * 64 + p], ar = apr[d * 64 + p], ai = api[d * 64 + p];
            const float er = cr * ar - cim * ai, ei = cr * ai + cim * ar; s += er * bbr[p * 16 + ci] - ei * bbi[p * 16 + ci]; }
        ktab[i] = s; }
    __syncthreads();
    { unsigned* dst = (unsigned*)((bf16*)(a.ws + WS_BT1) + (size_t)g * 128 * 128);
      for (int i = tid; i < 128 * 64; i += NTHREADS) { const int n = i >> 6, k = (i & 63) * 2, p = n & 63, im = n >> 6, t = k >> 4, c = k & 15;
          const float ar = apr[(7 - t) * 64 + p], ai = api[(7 - t) * 64 + p]; float v[2];
#pragma unroll
          for (int e = 0; e < 2; ++e) { const float br = bbr[p * 16 + c + e], bi = bbi[p * 16 + c + e]; v[e] = im ? (ar * bi + ai * br) : (ar * br - ai * bi); }
          dst[i] = pk2(v[0], v[1]); } }
    { unsigned* dst = (unsigned*)((bf16*)(a.ws + WS_BT2) + (size_t)g * 128 * 256);
      for (int i = tid; i < 128 * 128; i += NTHREADS) { const int n = i >> 7, k = (i & 127) * 2, to = n >> 4, co = n & 15; float v[2];
#pragma unroll
          for (int e = 0; e < 2; ++e) { const int kk = k + e; float x;
              if (kk < 128) { const int s = kk >> 4, ci = kk & 15, d = to - s; x = d >= 0 ? ktab[(d * 16 + co) * 16 + ci] : 0.f; if (d == 0 && ci == co) x += a.in[I_S5D][g * 16 + co]; }
              else { const int k2 = kk - 128, p = k2 & 63, im = k2 >> 6; const float cr = ccr[co * 64 + p], cim = cci[co * 64 + p], ar = apr[(to + 1) * 64 + p], ai = api[(to + 1) * 64 + p];
                  x = im ? -(cr * ai + cim * ar) : (cr * ar - cim * ai); }
              v[e] = x; }
          dst[i] = pk2(v[0], v[1]); } }
    __syncthreads();
}

__device__ __forceinline__ void p0_prologue(const Frame& F, const Args& a) {
    for (int it = F.vcu; it < 192 + 128 + 32; it += F.G) {
        if (it < 192) p0_mod_item(F, a, it);
        else if (it < 320) p0_s5prep_item(F, a, it - 192);
        else p0_wgate_item(F, a, it - 320);
    }
    __syncthreads();
    LAS float* scr = (LAS float*)(F.lds + F.wave * 16384);
    const int gw = F.vcu * NWAVES + F.wave, NGW = F.G * NWAVES;
    constexpr int I1 = (D / 64) * (D / 32), I2 = (D / 64) * (2 * D / 32), I3 = (D / 64) * (2 * FFH / 32), I4 = (FFH / 64) * (D / 32), I5 = (D / 64) * (2 * LRUW / 32), I6 = (LRUW / 64) * (D / 32);
    constexpr int NITEMS = I1 + I2 + 2 * I3 + 2 * I4 + I5 + I6;
    unsigned char* ws = a.ws;
    for (int it = gw; it < NITEMS; it += NGW) {
        int r = it;
        if (r < I1) { p0_transpose_item<0>(a.in[I_S5WIN], D, D, 0, (bf16*)(ws + WS_WS5IN), scr, r, F.lane); continue; } r -= I1;
        if (r < I2) { p0_transpose_item<1>(a.in[I_S5WGLU], D, 2 * D, D, (bf16*)(ws + WS_WGLU), scr, r, F.lane); continue; } r -= I2;
        if (r < I3) { p0_transpose_item<1>(a.in[I_FGU], D, 2 * FFH, FFH, (bf16*)(ws + WS_WGU0), scr, r, F.lane); continue; } r -= I3;
        if (r < I3) { p0_transpose_item<1>(a.in[I_FGU] + (size_t)D * 2 * FFH, D, 2 * FFH, FFH, (bf16*)(ws + WS_WGU1), scr, r, F.lane); continue; } r -= I3;
        if (r < I4) { p0_transpose_item<0>(a.in[I_FDN], FFH, D, 0, (bf16*)(ws + WS_WDN0), scr, r, F.lane); continue; } r -= I4;
        if (r < I4) { p0_transpose_item<0>(a.in[I_FDN] + (size_t)FFH * D, FFH, D, 0, (bf16*)(ws + WS_WDN1), scr, r, F.lane); continue; } r -= I4;
        if (r < I5) { p0_transpose_item<0>(a.in[I_LWIN], D, 2 * LRUW, 0, (bf16*)(ws + WS_WLIN), scr, r, F.lane); continue; } r -= I5;
        p0_transpose_item<0>(a.in[I_LWOUT], LRUW, D, 0, (bf16*)(ws + WS_WLOUT), scr, r, F.lane);
    }
}

__device__ __forceinline__ void norm_phase(const Frame& F, const float* x, const float* gain, const float* sh, const float* sc, bf16* H) {
    const int gw = F.vcu * NWAVES + F.wave, NGW = F.G * NWAVES;
    for (int r0 = gw * 4; r0 < M; r0 += NGW * 4) {
        const int b = r0 >> 11;
        f32x4 mul[8], add[8];
#pragma unroll
        for (int j = 0; j < 8; ++j) { const int k = 256 * j + 4 * F.lane; const f32x4 g = *(const f32x4*)(gain + k), s = *(const f32x4*)(sc + b * NMOD + k); mul[j] = g * (1.0f + s); add[j] = *(const f32x4*)(sh + b * NMOD + k); }
        for (int rr = 0; rr < 4; ++rr) { const int r = r0 + rr; const f32x4* xr = (const f32x4*)(x + (size_t)r * D) + F.lane;
            f32x4 v[8]; float s = 0.f;
#pragma unroll
            for (int j = 0; j < 8; ++j) { v[j] = xr[64 * j]; s += (v[j].x * v[j].x + v[j].y * v[j].y) + (v[j].z * v[j].z + v[j].w * v[j].w); }
            const float rstd = 1.0f / sqrtf(wave_sum(s) * (1.0f / D) + EPS);
            v2u* o = (v2u*)(H + (size_t)r * D) + F.lane;
#pragma unroll
            for (int j = 0; j < 8; ++j) { const f32x4 y = v[j] * rstd * mul[j] + add[j]; v2u w; w.x = pk2(y.x, y.y); w.y = pk2(y.z, y.w); o[64 * j] = w; } }
    }
}
__device__ __forceinline__ void final_norm_phase(const Frame& F, const float* x, const float* gain, float* out) {
    const int gw = F.vcu * NWAVES + F.wave, NGW = F.G * NWAVES;
    for (int r = gw; r < M; r += NGW) { const f32x4* xr = (const f32x4*)(x + (size_t)r * D) + F.lane;
        f32x4 v[8]; float s = 0.f;
#pragma unroll
        for (int j = 0; j < 8; ++j) { v[j] = xr[64 * j]; s += (v[j].x * v[j].x + v[j].y * v[j].y) + (v[j].z * v[j].z + v[j].w * v[j].w); }
        const float rstd = 1.0f / sqrtf(wave_sum(s) * (1.0f / D) + EPS);
        f32x4* o = (f32x4*)(out + (size_t)r * D) + F.lane;
#pragma unroll
        for (int j = 0; j < 8; ++j) o[64 * j] = v[j] * rstd * *(const f32x4*)(gain + 256 * j + 4 * F.lane); }
}

constexpr int S5_UP = 272, S5_SP = 528, S5_SOFF = 128 * S5_UP;
__device__ __forceinline__ void s5_item(const Frame& F, const Args& a, int item) {
    const int b = item >> 7, g = item & 127, w = F.wave, lane = F.lane, fr = lane & 15, fq = lane >> 4;
    LAS unsigned char* Uc = F.lds; LAS unsigned char* S = F.lds + S5_SOFF;
    const bf16* Bt1 = (const bf16*)(a.ws + WS_BT1) + (size_t)g * 128 * 128; const bf16* Bt2 = (const bf16*)(a.ws + WS_BT2) + (size_t)g * 128 * 256;
    bf16x8 B1[4], B2[8];
#pragma unroll
    for (int kk = 0; kk < 4; ++kk) B1[kk] = *(const bf16x8*)(Bt1 + (16 * w + fr) * 128 + 32 * kk + 8 * fq);
#pragma unroll
    for (int kk = 0; kk < 8; ++kk) B2[kk] = *(const bf16x8*)(Bt2 + (16 * w + fr) * 256 + 32 * kk + 8 * fq);
    float aTr = 0.f, aTi = 0.f, sr = 0.f, si = 0.f;
    if (w == 0) { const float* at = (const float*)(a.ws + WS_AT) + (g * 64 + lane) * 2; aTr = at[0]; aTi = at[1]; }
    const bf16* UG = (const bf16*)(a.ws + WS_UG) + (size_t)(b * 128 + g) * 2048 * 16;
    bf16* Y = (bf16*)(a.ws + WS_Y);
    for (int hf = 0; hf < 2; ++hf) {
        const v4u* src = (const v4u*)(UG + (size_t)hf * 1024 * 16);
#pragma unroll
        for (int i = 0; i < 4; ++i) { const int piece = F.tid + 512 * i, row = piece >> 4, c16 = piece & 15; *(LAS v4u*)(Uc + row * S5_UP + c16 * 16) = src[piece]; }
        LDS_BARRIER();
#pragma unroll 2
        for (int mt = 0; mt < 8; ++mt) { f32x4 acc = {0.f, 0.f, 0.f, 0.f};
#pragma unroll
            for (int kk = 0; kk < 4; ++kk) { const bf16x8 av = *(const LAS bf16x8*)(Uc + (16 * mt + fr) * S5_UP + (32 * kk + 8 * fq) * 2); acc = __builtin_amdgcn_mfma_f32_16x16x32_bf16(B1[kk], av, acc, 0, 0, 0); }
            *(LAS f32x4*)(S + (16 * mt + fr) * S5_SP + (16 * w + 4 * fq) * 4) = acc; }
        LDS_BARRIER();
        if (w == 0) {
            for (int j0 = 0; j0 < 128; j0 += 8) { float er[8], ei[8];
#pragma unroll
                for (int q = 0; q < 8; ++q) { LAS unsigned char* row = S + (j0 + q) * S5_SP; er[q] = *(const LAS float*)(row + 4 * lane); ei[q] = *(const LAS float*)(row + 256 + 4 * lane); }
                asm volatile("s_waitcnt lgkmcnt(0)" ::: "memory");
#pragma unroll
                for (int q = 0; q < 8; ++q) { LAS unsigned char* row = S + (j0 + q) * S5_SP;
                    *(LAS bf16*)(row + 2 * lane) = (bf16)f2bf(sr); *(LAS bf16*)(row + 128 + 2 * lane) = (bf16)f2bf(si);
                    const float nr = aTr * sr - aTi * si + er[q], ni = aTr * si + aTi * sr + ei[q]; sr = nr; si = ni; } }
        }
        LDS_BARRIER();
#pragma unroll 2
        for (int mt = 0; mt < 8; ++mt) { f32x4 acc = {0.f, 0.f, 0.f, 0.f};
#pragma unroll
            for (int kk = 0; kk < 4; ++kk) { const bf16x8 av = *(const LAS bf16x8*)(Uc + (16 * mt + fr) * S5_UP + (32 * kk + 8 * fq) * 2); acc = __builtin_amdgcn_mfma_f32_16x16x32_bf16(B2[kk], av, acc, 0, 0, 0); }
#pragma unroll
            for (int kk = 0; kk < 4; ++kk) { const bf16x8 av = *(const LAS bf16x8*)(S + (16 * mt + fr) * S5_SP + (32 * kk + 8 * fq) * 2); acc = __builtin_amdgcn_mfma_f32_16x16x32_bf16(B2[4 + kk], av, acc, 0, 0, 0); }
            const int tok = b * 2048 + hf * 1024 + 8 * (16 * mt + fr) + w;
            v2u o; o.x = pk2(pg8::gelu_tanh(acc[0]), pg8::gelu_tanh(acc[1])); o.y = pk2(pg8::gelu_tanh(acc[2]), pg8::gelu_tanh(acc[3]));
            *(v2u*)(Y + (size_t)tok * D + 16 * g + 4 * fq) = o; }
        LDS_BARRIER();
    }
}

constexpr int L_AP = 400, L_ABUF = 128 * L_AP, L_SP = 352, L_PS = L_ABUF, L_QS = L_PS + 128 * L_SP, L_CONST = L_QS + 128 * L_SP, L_CWL = L_CONST + 176 * 16;
static_assert(L_CWL + 5 * 176 * 4 <= MISC_OFF, "LRU LDS map");
template <int CTRL> __device__ __forceinline__ float dpp_f(float old, float src) { return __builtin_bit_cast(float, __builtin_amdgcn_update_dpp(__builtin_bit_cast(int, old), __builtin_bit_cast(int, src), CTRL, 0xf, 0xf, false)); }
__device__ __forceinline__ void lruA_phase(const Frame& F, const Args& a) {
    const int w = F.wave, lane = F.lane, fr = lane & 15, fq = lane >> 4, tid = F.tid;
    const int h = F.vcu & 15;
    LAS float* CONST = (LAS float*)(F.lds + L_CONST);
    for (int i = tid; i < 176; i += NTHREADS) { const int ch = 176 * h + i; const float lam = a.in[I_LLAM][ch]; const float sp = lam < -20.f ? -lam : log1pf(expf(-lam));
        CONST[4 * i] = -8.0f * sp; CONST[4 * i + 1] = a.in[I_LBRG][ch]; CONST[4 * i + 2] = a.in[I_LBIG][ch]; CONST[4 * i + 3] = 0.f; }
    for (int i = tid; i < 128 * 2; i += NTHREADS) { const int row = i >> 1, c16 = i & 1; *(LAS v4u*)(F.lds + row * L_AP + 352 + c16 * 16) = (v4u){0u, 0u, 0u, 0u}; }
    const int quad = tid % 44, rg8 = tid / 44;
    LAS float* CWL = (LAS float*)(F.lds + L_CWL);
    for (int i = tid; i < 5 * 176; i += NTHREADS) { const int k = i / 176, ch = i % 176; CWL[i] = k < 4 ? a.in[I_LCW][k * LRUW + 176 * h + ch] : a.in[I_LCB][176 * h + ch]; }
    const bf16* XB = (const bf16*)(a.ws + WS_XB); const bf16* GG = (const bf16*)(a.ws + WS_GG); bf16* PB = (bf16*)(a.ws + WS_P); bf16* QB = (bf16*)(a.ws + WS_Q);
    f32x2* TOTG = (f32x2*)(a.ws + WS_TOTG);
    const bf16* WG2 = (const bf16*)(a.ws + WS_WGATE) + (size_t)h * 2 * 176 * 192;
    const int mg = w >> 2, cs = w & 3, ct0 = 3 * cs, ct1 = cs < 3 ? ct0 + 3 : 11;
    v2u raw[19]; bf16x8 wr[6], wi[6]; v2u ggn[4];
#define LRU_LOAD_RAW(ITEM) do { const int tix_ = (ITEM) >> 4, b_ = tix_ >> 4, tb_ = (tix_ & 15) * 128 + 16 * rg8; \
        const bf16* src_ = XB + (size_t)(b_ * 2048 + tb_ - 3) * LRUW + 176 * h + 4 * quad; \
        _Pragma("unroll") for (int r = 0; r < 19; ++r) { raw[r] = (v2u){0u, 0u}; if (tb_ - 3 + r >= 0) raw[r] = *(const v2u*)(src_ + (size_t)r * LRUW); } } while (0)
#define LRU_CONV(ABUF) do { f32x4 cw[4]; _Pragma("unroll") for (int k = 0; k < 4; ++k) cw[k] = *(const LAS f32x4*)(CWL + k * 176 + 4 * quad); const f32x4 cb = *(const LAS f32x4*)(CWL + 4 * 176 + 4 * quad); \
        _Pragma("unroll") for (int r = 0; r < 16; ++r) { float o[4] = {cb[0], cb[1], cb[2], cb[3]}; \
            _Pragma("unroll") for (int k = 0; k < 4; ++k) { const v2u v = raw[r + k]; \
                o[0] += cw[k][0] * bf2f((unsigned short)(v.x & 0xffffu)); o[1] += cw[k][1] * bf2f((unsigned short)(v.x >> 16)); \
                o[2] += cw[k][2] * bf2f((unsigned short)(v.y & 0xffffu)); o[3] += cw[k][3] * bf2f((unsigned short)(v.y >> 16)); } \
            v2u ov; ov.x = pk2(o[0], o[1]); ov.y = pk2(o[2], o[3]); *(LAS v2u*)((ABUF) + (16 * rg8 + r) * L_AP + quad * 8) = ov; } } while (0)
#define LRU_LOAD_W(CT) do { _Pragma("unroll") for (int kk = 0; kk < 6; ++kk) { wr[kk] = *(const bf16x8*)(WG2 + (size_t)(16 * (CT) + fr) * 192 + 32 * kk + 8 * fq); \
            wi[kk] = *(const bf16x8*)(WG2 + (size_t)(176 + 16 * (CT) + fr) * 192 + 32 * kk + 8 * fq); } } while (0)
#define LRU_LOAD_GG(ITEM, CT) do { const int tix_ = (ITEM) >> 4; const size_t tokb_ = (size_t)((tix_ >> 4) * 2048 + (tix_ & 15) * 128 + 64 * mg + fr); \
        _Pragma("unroll") for (int mt = 0; mt < 4; ++mt) ggn[mt] = *(const v2u*)(GG + (tokb_ + 16 * mt) * LRUW + 176 * h + 16 * (CT) + 4 * fq); } while (0)
    __syncthreads();
    if (tid < 352) { LRU_LOAD_RAW(F.vcu); LRU_CONV(F.lds); }
    LRU_LOAD_W(ct0); LRU_LOAD_GG(F.vcu, ct0);
    __syncthreads();
    int it_n = 0;
    for (int item = F.vcu; item < 1024; item += F.G, ++it_n) {
        const int tix = item >> 4, b = tix >> 4, tile = tix & 15, t0 = tile * 128;
        const int nitem = item + F.G; const bool has_next = nitem < 1024;
        LAS unsigned char* A = F.lds;
        if (has_next && tid < 352) LRU_LOAD_RAW(nitem);
        const int chunk = tile * 2 + mg;
        for (int ct = ct0; ct < ct1; ++ct) {
            const size_t tokb = (size_t)(b * 2048 + t0 + 64 * mg + fr);
            const int chb = 176 * h + 16 * ct + 4 * fq;
            v2u ggr[4];
#pragma unroll
            for (int mt = 0; mt < 4; ++mt) ggr[mt] = ggn[mt];
            f32x4 ar[4], ai[4];
#pragma unroll
            for (int mt = 0; mt < 4; ++mt) { ar[mt] = (f32x4){0.f, 0.f, 0.f, 0.f}; ai[mt] = (f32x4){0.f, 0.f, 0.f, 0.f}; }
#pragma unroll
            for (int kk = 0; kk < 6; ++kk)
#pragma unroll
                for (int mt = 0; mt < 4; ++mt) { const bf16x8 av = *(const LAS bf16x8*)(A + (64 * mg + 16 * mt + fr) * L_AP + (32 * kk + 8 * fq) * 2);
                    ar[mt] = __builtin_amdgcn_mfma_f32_16x16x32_bf16(wr[kk], av, ar[mt], 0, 0, 0); ai[mt] = __builtin_amdgcn_mfma_f32_16x16x32_bf16(wi[kk], av, ai[mt], 0, 0, 0); }
            { const bool more = ct + 1 < ct1; const int nct = more ? ct + 1 : ct0;
              asm volatile("" : "+v"(ar[3]), "+v"(ai[3]));
              LRU_LOAD_W(nct); if (more) LRU_LOAD_GG(item, nct); else if (has_next) LRU_LOAD_GG(nitem, nct); }
            f32x4 cst[4];
#pragma unroll
            for (int i = 0; i < 4; ++i) cst[i] = *(const LAS f32x4*)(CONST + 4 * (16 * ct + 4 * fq + i));
            float Ac[4] = {1.f, 1.f, 1.f, 1.f}, Bc[4] = {0.f, 0.f, 0.f, 0.f};
#pragma unroll
            for (int mt = 0; mt < 4; ++mt) {
                const v2u xr = *(const LAS v2u*)(A + (64 * mg + 16 * mt + fr) * L_AP + (16 * ct + 4 * fq) * 2);
                const float xc[4] = {bf2f((unsigned short)(xr.x & 0xffffu)), bf2f((unsigned short)(xr.x >> 16)), bf2f((unsigned short)(xr.y & 0xffffu)), bf2f((unsigned short)(xr.y >> 16))};
                const float gg[4] = {bf2f((unsigned short)(ggr[mt].x & 0xffffu)), bf2f((unsigned short)(ggr[mt].x >> 16)), bf2f((unsigned short)(ggr[mt].y & 0xffffu)), bf2f((unsigned short)(ggr[mt].y >> 16))};
                float P4[4], Q4[4], av[4], bv[4];
#pragma unroll
                for (int i = 0; i < 4; ++i) {
                    const float r = pg8::sigmoidf_(ar[mt][i] + cst[i].y), ig = pg8::sigmoidf_(ai[mt][i] + cst[i].z);
                    const float la = cst[i].x * r, x2 = 2.0f * la;
                    av[i] = __expf(la);
                    const float em1 = x2 * (1.0f + x2 * (0.5f + x2 * (0.16666667f + x2 * (0.041666668f + x2 * 0.0083333338f))));
                    bv[i] = __builtin_amdgcn_sqrtf(-em1) * ig * xc[i];
                }
#define LRU_DPP_STEP(S) \
                    "v_fmac_f32_dpp %4, %4, %0 row_shr:" #S " row_mask:0xf bank_mask:0xf\n\t" "v_fmac_f32_dpp %5, %5, %1 row_shr:" #S " row_mask:0xf bank_mask:0xf\n\t" \
                    "v_fmac_f32_dpp %6, %6, %2 row_shr:" #S " row_mask:0xf bank_mask:0xf\n\t" "v_fmac_f32_dpp %7, %7, %3 row_shr:" #S " row_mask:0xf bank_mask:0xf\n\t" \
                    "v_mul_f32_dpp %0, %0, %0 row_shr:" #S " row_mask:0xf bank_mask:0xf\n\t" "v_mul_f32_dpp %1, %1, %1 row_shr:" #S " row_mask:0xf bank_mask:0xf\n\t" \
                    "v_mul_f32_dpp %2, %2, %2 row_shr:" #S " row_mask:0xf bank_mask:0xf\n\t" "v_mul_f32_dpp %3, %3, %3 row_shr:" #S " row_mask:0xf bank_mask:0xf\n\t"
                asm volatile("s_nop 1\n\t" LRU_DPP_STEP(1) LRU_DPP_STEP(2) LRU_DPP_STEP(4) LRU_DPP_STEP(8) "s_nop 1"
                             : "+v"(av[0]), "+v"(av[1]), "+v"(av[2]), "+v"(av[3]), "+v"(bv[0]), "+v"(bv[1]), "+v"(bv[2]), "+v"(bv[3]));
#undef LRU_DPP_STEP
#pragma unroll
                for (int i = 0; i < 4; ++i) {
                    const float hl = bv[i] + av[i] * Bc[i], ca = av[i] * Ac[i];
                    Ac[i] = __shfl(ca, 15, 16); Bc[i] = __shfl(hl, 15, 16);
                    P4[i] = hl * gg[i]; Q4[i] = ca * gg[i];
                }
                v2u po, qo; po.x = pk2(P4[0], P4[1]); po.y = pk2(P4[2], P4[3]); qo.x = pk2(Q4[0], Q4[1]); qo.y = pk2(Q4[2], Q4[3]);
                const int so = (64 * mg + 16 * mt + fr) * L_SP + (16 * ct + 4 * fq) * 2;
                *(LAS v2u*)(F.lds + L_PS + so) = po; *(LAS v2u*)(F.lds + L_QS + so) = qo;
            }
            if (fr == 15) {
#pragma unroll
                for (int i = 0; i < 4; ++i) TOTG[(size_t)(b * 32 + chunk) * LRUW + chb + i] = (f32x2){Ac[i], Bc[i]}; }
        }
        LDS_BARRIER();
        if (has_next && tid < 352) LRU_CONV(F.lds);
#pragma unroll
        for (int j = 0; j < 11; ++j) { const int p = tid + NTHREADS * j, which = p >= 2816, pp = which ? p - 2816 : p, row = pp / 22, c16 = pp % 22;
            const v4u v = *(const LAS v4u*)(F.lds + (which ? L_QS : L_PS) + row * L_SP + c16 * 16);
            *(v4u*)((which ? QB : PB) + (size_t)(b * 2048 + t0 + row) * LRUW + 176 * h + 8 * c16) = v; }
        LDS_BARRIER();
    }
#undef LRU_LOAD_RAW
#undef LRU_CONV
#undef LRU_LOAD_W
#undef LRU_LOAD_GG
}
__device__ __forceinline__ void lruB_phase(const Frame& F, const Args& a) {
    const bf16* PB = (const bf16*)(a.ws + WS_P); const bf16* QB = (const bf16*)(a.ws + WS_Q); bf16* YL = (bf16*)(a.ws + WS_YL);
    const f32x4* TOTG = (const f32x4*)(a.ws + WS_TOTG);
    const int NIT = BATCH * 32 * 2 * 352, gt = F.vcu * NTHREADS + F.tid, NT = F.G * NTHREADS;
    for (int it = gt; it < NIT; it += NT) {
        const int cg = it % 352, r1 = it / 352, tq = r1 & 1, r2 = r1 >> 1, chunk = r2 & 31, b = r2 >> 5;
        float hin[8] = {0.f, 0.f, 0.f, 0.f, 0.f, 0.f, 0.f, 0.f};
        for (int jj = 0; jj < chunk; ++jj) { const f32x4* t = TOTG + ((size_t)(b * 32 + jj) * LRUW + 8 * cg) / 2;
#pragma unroll
            for (int e = 0; e < 4; ++e) { const f32x4 v = t[e]; hin[2 * e] = v.x * hin[2 * e] + v.y; hin[2 * e + 1] = v.z * hin[2 * e + 1] + v.w; } }
        const size_t base = (size_t)(b * 2048 + chunk * 64 + tq * 32) * LRUW + 8 * cg;
#pragma unroll 8
        for (int tt = 0; tt < 32; ++tt) { const v4u p = *(const v4u*)(PB + base + (size_t)tt * LRUW), q = *(const v4u*)(QB + base + (size_t)tt * LRUW); v4u o;
#pragma unroll
            for (int e = 0; e < 4; ++e) { const unsigned pw = p[e], qw = q[e];
                const float y0 = bf2f((unsigned short)(pw & 0xffffu)) + bf2f((unsigned short)(qw & 0xffffu)) * hin[2 * e], y1 = bf2f((unsigned short)(pw >> 16)) + bf2f((unsigned short)(qw >> 16)) * hin[2 * e + 1];
                o[e] = pk2(y0, y1); }
            *(v4u*)(YL + base + (size_t)tt * LRUW) = o; }
    }
}
#define XB_TMO      128
#define XB_XCNT(j)  (256  + 64 * (j))
#define XB_XSUB(j)  (1280 + 64 * (j))
#define XB_XGEN(j)  (2304 + 64 * (j))
#define XB_TOP      3328
#define XB_TOPGEN   3392
#define XCD_BAR_WORDS 3456
#define XB_SPIN_CAP (1u << 18)

__device__ __forceinline__ unsigned xb_ld(unsigned* p)              { return __hip_atomic_load(p, __ATOMIC_RELAXED, __HIP_MEMORY_SCOPE_AGENT); }
__device__ __forceinline__ unsigned xb_add(unsigned* p, unsigned v) { return __hip_atomic_fetch_add(p, v, __ATOMIC_RELAXED, __HIP_MEMORY_SCOPE_AGENT); }
__device__ __forceinline__ unsigned xb_xcc_id() { return (unsigned)__builtin_amdgcn_s_getreg((3 << 11) | 20) & 0xFu; }
#define XB_SPIN(cond, bar) do { unsigned _sp = 0; while (cond) { __builtin_amdgcn_s_sleep(1); \
    if ((++_sp & 255u) == 0u) { if (xb_ld(&(bar)[XB_TMO])) break; if (_sp > XB_SPIN_CAP) { atomicAdd(&(bar)[XB_TMO], 1u); break; } } } } while (0)

struct XcdBarrier {
    unsigned* bar; unsigned x;
    volatile LAS unsigned* st;
};

__device__ __forceinline__ XcdBarrier xcd_barrier_post(unsigned* bar, volatile LAS unsigned* st) {
    XcdBarrier b; b.bar = bar; b.x = xb_xcc_id(); b.st = st;
    if (threadIdx.x == 0) (void)xb_add(&bar[XB_XCNT(b.x)], 1u);
    return b;
}
__device__ __forceinline__ void xcd_barrier_complete(unsigned* bar, unsigned x, unsigned& nloc, unsigned& nx) {
    const unsigned G = gridDim.x * gridDim.y * gridDim.z;
    unsigned sum, cnt, mine, sp = 0u;
    for (;;) {
        sum = 0u; cnt = 0u; mine = 0u;
#pragma unroll
        for (unsigned j = 0; j < 16; ++j) { const unsigned c = xb_ld(&bar[XB_XCNT(j)]); sum += c; cnt += (c > 0u) ? 1u : 0u; mine = (j == x) ? c : mine; }
        if (sum == G) break;
        __builtin_amdgcn_s_sleep(1);
        if ((++sp & 255u) == 0u) { if (xb_ld(&bar[XB_TMO])) break; if (sp > XB_SPIN_CAP) { atomicAdd(&bar[XB_TMO], 1u); break; } }
    }
    nloc = mine > 0u ? mine : 1u; nx = cnt > 0u ? cnt : 1u;
}

__device__ __forceinline__ void xcd_barrier(const XcdBarrier& b) {
    asm volatile("s_waitcnt vmcnt(0)" ::: "memory");
    __syncthreads();
    if (threadIdx.x == 0) {
        unsigned* bar = b.bar;
        __builtin_amdgcn_s_waitcnt(0);
        unsigned nloc = b.st[0], nx = b.st[1];
        if (nloc == 0u) { xcd_barrier_complete(bar, b.x, nloc, nx); b.st[0] = nloc; b.st[1] = nx; }
        const unsigned old = xb_add(&bar[XB_XSUB(b.x)], 1u);
        const unsigned gen = old / nloc;
        if (old + 1u == (gen + 1u) * nloc) {
            __builtin_amdgcn_fence(__ATOMIC_RELEASE, "agent");
            asm volatile("s_waitcnt vmcnt(0)" ::: "memory");
            const unsigned og = xb_add(&bar[XB_TOP], 1u);
            const unsigned tg = og / nx;
            if (og + 1u == (tg + 1u) * nx) xb_add(&bar[XB_TOPGEN], 1u);
            else XB_SPIN(xb_ld(&bar[XB_TOPGEN]) == tg, bar);
            __builtin_amdgcn_fence(__ATOMIC_ACQUIRE, "agent");
            xb_add(&bar[XB_XGEN(b.x)], 1u);
            asm volatile("s_waitcnt vmcnt(0)" ::: "memory");
        } else {
            XB_SPIN(xb_ld(&bar[XB_XGEN(b.x)]) == gen, bar);
            __builtin_amdgcn_fence(__ATOMIC_ACQUIRE, "agent");
            asm volatile("s_waitcnt vmcnt(0)" ::: "memory");
        }
    }
    __syncthreads();
}
__global__ void __launch_bounds__(NTHREADS, 2) fwd_kernel(Args args) {
    extern __shared__ __attribute__((aligned(16))) unsigned char lds[];
    Frame F;
    F.lds = (LAS unsigned char*)lds;
    F.tid = threadIdx.x; F.lane = F.tid & 63; F.wave = __builtin_amdgcn_readfirstlane(F.tid >> 6);
    F.G = gridDim.x; { const int bx = blockIdx.x; F.vcu = (F.G % 8 == 0) ? (bx % 8) * (F.G / 8) + bx / 8 : bx; }
    unsigned char* ws = args.ws;
    const int lo = args.ph_lo, hi = args.ph_hi;
#if MK_N_LAUNCHES == 1
    volatile LAS unsigned* MISC = (volatile LAS unsigned*)(F.lds + MISC_OFF);
    if (F.tid < 8) MISC[F.tid] = 0u;
    __syncthreads();
    XcdBarrier bar = xcd_barrier_post((unsigned*)(ws + WS_CTL) + CW_BAR, MISC);
#if USE_CG_SYNC
    cg::grid_group grid = cg::this_grid();
#define GRID_BAR() grid.sync()
#else
#define GRID_BAR() xcd_barrier(bar)
#endif
#else
#define GRID_BAR() do {} while (0)
#endif
#define IN(k) (lo <= (k) && (k) < hi)
#ifndef PROBE_MASK
#define PROBE_MASK 0
#endif
#define NREP(k) (1 + ((PROBE_MASK >> (k)) & 1))
#define LASTREP(k) (rep_ + 1 == NREP(k))
#define FORREP(k) for (int rep_ = 0; rep_ < NREP(k); ++rep_, (rep_ < NREP(k) ? (GRID_BAR(), 0) : 0))
    float* XD = (float*)(ws + WS_DUMMY);
#ifdef PROBE_BAR2
#define SEAM(k) do { if (IN(k) && IN((k) + 1)) { GRID_BAR(); GRID_BAR(); } } while (0)
#else
#define SEAM(k) do { if (IN(k) && IN((k) + 1)) GRID_BAR(); } while (0)
#endif
    const float* mod = (const float*)(ws + WS_MOD);
    float* X = (float*)(ws + WS_X); bf16* H = (bf16*)(ws + WS_H);
    const float* x_in = args.in[I_X];

    if (IN(0)) {
#if (PROBE_MASK >> 0) & 1
        { p0_prologue(F, args); }
        GRID_BAR();
#endif
        { p0_prologue(F, args); }
    } SEAM(0);
    if (IN(1)) {
#if (PROBE_MASK >> 1) & 1
        { norm_phase(F, x_in, args.in[I_NORMG] + 0 * D, mod + 0 * D, mod + 1 * D, H); }
        GRID_BAR();
#endif
        { norm_phase(F, x_in, args.in[I_NORMG] + 0 * D, mod + 0 * D, mod + 1 * D, H); }
    } SEAM(1);
    if (IN(2)) {
#if (PROBE_MASK >> 2) & 1
        { pg8::Gemm g{H, (const bf16*)(ws + WS_WS5IN), M, D, D}; pg8::StaticOrder S; S.init(M, D, F.G, (int)blockIdx.x);
        pg8::EpiS5U E{(bf16*)(ws + WS_UG)}; pg8::gemm_phase<pg8::EpiS5U, pg8::StaticOrder, true, true>(F.lds, g, S, E); }
        GRID_BAR();
#endif
        { pg8::Gemm g{H, (const bf16*)(ws + WS_WS5IN), M, D, D}; pg8::StaticOrder S; S.init(M, D, F.G, (int)blockIdx.x);
        pg8::EpiS5U E{(bf16*)(ws + WS_UG)}; pg8::gemm_phase<pg8::EpiS5U, pg8::StaticOrder, true, true>(F.lds, g, S, E); }
    } SEAM(2);
    if (IN(3)) {
#if (PROBE_MASK >> 3) & 1
        { for (int it = F.vcu; it < BATCH * S5G; it += F.G) s5_item(F, args, it); }
        GRID_BAR();
#endif
        { for (int it = F.vcu; it < BATCH * S5G; it += F.G) s5_item(F, args, it); }
    } SEAM(3);
    if (IN(4)) {
#if (PROBE_MASK >> 4) & 1
        { pg8::Gemm g{(const bf16*)(ws + WS_Y), (const bf16*)(ws + WS_WGLU), M, 2 * D, D}; pg8::StaticOrder S; S.init(M, 2 * D, F.G, (int)blockIdx.x);
        pg8::EpiGluRes E{x_in, X, mod + 2 * D}; pg8::gemm_phase<pg8::EpiGluRes, pg8::StaticOrder, true, true>(F.lds, g, S, E); }
        GRID_BAR();
#endif
        { pg8::Gemm g{(const bf16*)(ws + WS_Y), (const bf16*)(ws + WS_WGLU), M, 2 * D, D}; pg8::StaticOrder S; S.init(M, 2 * D, F.G, (int)blockIdx.x);
        pg8::EpiGluRes E{x_in, X, mod + 2 * D}; pg8::gemm_phase<pg8::EpiGluRes, pg8::StaticOrder, true, true>(F.lds, g, S, E); }
    } SEAM(4);
    if (IN(5)) {
#if (PROBE_MASK >> 5) & 1
        { norm_phase(F, X, args.in[I_NORMG] + 1 * D, mod + 3 * D, mod + 4 * D, H); }
        GRID_BAR();
#endif
        { norm_phase(F, X, args.in[I_NORMG] + 1 * D, mod + 3 * D, mod + 4 * D, H); }
    } SEAM(5);
    if (IN(6)) {
#if (PROBE_MASK >> 6) & 1
        { pg8::Gemm g{H, (const bf16*)(ws + WS_WGU0), M, 2 * FFH, D}; pg8::StaticOrder S; S.init(M, 2 * FFH, F.G, (int)blockIdx.x);
        pg8::EpiSwiGlu E{(bf16*)(ws + WS_HID), FFH}; pg8::gemm_phase<pg8::EpiSwiGlu, pg8::StaticOrder, true, true>(F.lds, g, S, E); }
        GRID_BAR();
#endif
        { pg8::Gemm g{H, (const bf16*)(ws + WS_WGU0), M, 2 * FFH, D}; pg8::StaticOrder S; S.init(M, 2 * FFH, F.G, (int)blockIdx.x);
        pg8::EpiSwiGlu E{(bf16*)(ws + WS_HID), FFH}; pg8::gemm_phase<pg8::EpiSwiGlu, pg8::StaticOrder, true, true>(F.lds, g, S, E); }
    } SEAM(6);
    if (IN(7)) {
#if (PROBE_MASK >> 7) & 1
        { pg8::Gemm g{(const bf16*)(ws + WS_HID), (const bf16*)(ws + WS_WDN0), M, D, FFH}; pg8::StaticOrder S; S.init(M, D, F.G, (int)blockIdx.x);
        pg8::EpiRes E{X, XD, mod + 5 * D}; pg8::gemm_phase<pg8::EpiRes, pg8::StaticOrder, true, true>(F.lds, g, S, E); }
        GRID_BAR();
#endif
        { pg8::Gemm g{(const bf16*)(ws + WS_HID), (const bf16*)(ws + WS_WDN0), M, D, FFH}; pg8::StaticOrder S; S.init(M, D, F.G, (int)blockIdx.x);
        pg8::EpiRes E{X, X, mod + 5 * D}; pg8::gemm_phase<pg8::EpiRes, pg8::StaticOrder, true, true>(F.lds, g, S, E); }
    } SEAM(7);
    const float* mod1 = mod + 4 * NMOD;
    if (IN(8)) {
#if (PROBE_MASK >> 8) & 1
        { norm_phase(F, X, args.in[I_NORMG] + 2 * D, mod1 + 0 * D, mod1 + 1 * D, H); }
        GRID_BAR();
#endif
        { norm_phase(F, X, args.in[I_NORMG] + 2 * D, mod1 + 0 * D, mod1 + 1 * D, H); }
    } SEAM(8);
    if (IN(9)) {
#if (PROBE_MASK >> 9) & 1
        { pg8::Gemm g{H, (const bf16*)(ws + WS_WLIN), M, 2 * LRUW, D}; pg8::StaticOrder S; S.init(M, 2 * LRUW, F.G, (int)blockIdx.x);
        pg8::EpiLruIn E{(bf16*)(ws + WS_GG), (bf16*)(ws + WS_XB)}; pg8::gemm_phase<pg8::EpiLruIn, pg8::StaticOrder, true, true>(F.lds, g, S, E); }
        GRID_BAR();
#endif
        { pg8::Gemm g{H, (const bf16*)(ws + WS_WLIN), M, 2 * LRUW, D}; pg8::StaticOrder S; S.init(M, 2 * LRUW, F.G, (int)blockIdx.x);
        pg8::EpiLruIn E{(bf16*)(ws + WS_GG), (bf16*)(ws + WS_XB)}; pg8::gemm_phase<pg8::EpiLruIn, pg8::StaticOrder, true, true>(F.lds, g, S, E); }
    } SEAM(9);
#ifdef PROBE_LRUA
    if (IN(10)) { lruA_phase(F, args); GRID_BAR(); }
#endif
    if (IN(10)) { lruA_phase(F, args); } SEAM(10);
    if (IN(11)) {
#if (PROBE_MASK >> 11) & 1
        { lruB_phase(F, args); }
        GRID_BAR();
#endif
        { lruB_phase(F, args); }
    } SEAM(11);
    if (IN(12)) {
#if (PROBE_MASK >> 12) & 1
        { pg8::Gemm g{(const bf16*)(ws + WS_YL), (const bf16*)(ws + WS_WLOUT), M, D, LRUW}; pg8::StaticOrder S; S.init(M, D, F.G, (int)blockIdx.x);
        pg8::EpiRes E{X, XD, mod1 + 2 * D}; pg8::gemm_phase<pg8::EpiRes, pg8::StaticOrder, true, true>(F.lds, g, S, E); }
        GRID_BAR();
#endif
        { pg8::Gemm g{(const bf16*)(ws + WS_YL), (const bf16*)(ws + WS_WLOUT), M, D, LRUW}; pg8::StaticOrder S; S.init(M, D, F.G, (int)blockIdx.x);
        pg8::EpiRes E{X, X, mod1 + 2 * D}; pg8::gemm_phase<pg8::EpiRes, pg8::StaticOrder, true, true>(F.lds, g, S, E); }
    } SEAM(12);
    if (IN(13)) {
#if (PROBE_MASK >> 13) & 1
        { norm_phase(F, X, args.in[I_NORMG] + 3 * D, mod1 + 3 * D, mod1 + 4 * D, H); }
        GRID_BAR();
#endif
        { norm_phase(F, X, args.in[I_NORMG] + 3 * D, mod1 + 3 * D, mod1 + 4 * D, H); }
    } SEAM(13);
    if (IN(14)) {
#if (PROBE_MASK >> 14) & 1
        { pg8::Gemm g{H, (const bf16*)(ws + WS_WGU1), M, 2 * FFH, D}; pg8::StaticOrder S; S.init(M, 2 * FFH, F.G, (int)blockIdx.x);
        pg8::EpiSwiGlu E{(bf16*)(ws + WS_HID), FFH}; pg8::gemm_phase<pg8::EpiSwiGlu, pg8::StaticOrder, true, true>(F.lds, g, S, E); }
        GRID_BAR();
#endif
        { pg8::Gemm g{H, (const bf16*)(ws + WS_WGU1), M, 2 * FFH, D}; pg8::StaticOrder S; S.init(M, 2 * FFH, F.G, (int)blockIdx.x);
        pg8::EpiSwiGlu E{(bf16*)(ws + WS_HID), FFH}; pg8::gemm_phase<pg8::EpiSwiGlu, pg8::StaticOrder, true, true>(F.lds, g, S, E); }
    } SEAM(14);
    if (IN(15)) {
#if (PROBE_MASK >> 15) & 1
        { pg8::Gemm g{(const bf16*)(ws + WS_HID), (const bf16*)(ws + WS_WDN1), M, D, FFH}; pg8::StaticOrder S; S.init(M, D, F.G, (int)blockIdx.x);
        pg8::EpiRes E{X, XD, mod1 + 5 * D}; pg8::gemm_phase<pg8::EpiRes, pg8::StaticOrder, true, true>(F.lds, g, S, E); }
        GRID_BAR();
#endif
        { pg8::Gemm g{(const bf16*)(ws + WS_HID), (const bf16*)(ws + WS_WDN1), M, D, FFH}; pg8::StaticOrder S; S.init(M, D, F.G, (int)blockIdx.x);
        pg8::EpiRes E{X, X, mod1 + 5 * D}; pg8::gemm_phase<pg8::EpiRes, pg8::StaticOrder, true, true>(F.lds, g, S, E); }
    } SEAM(15);
    if (IN(16)) { final_norm_phase(F, X, args.in[I_FINALG], args.out); }
#undef IN
#undef SEAM
}

extern "C" void kernel_launch(void* const* d_in, const int* in_sizes, int n_in, void* d_out, int out_size, void* d_ws, size_t ws_size, hipStream_t stream) {
    static int grid = 0;
    if (grid == 0) {
        if (n_in != 27 || out_size != M * D || ws_size < WS_END) { fprintf(stderr, "kernel_launch: unexpected shapes (n_in %d out %d ws %zu)\n", n_in, out_size, ws_size); grid = -1; return; }
        int dev = 0, cus = 0, per_cu = 0;
        if (hipGetDevice(&dev) != hipSuccess || hipDeviceGetAttribute(&cus, hipDeviceAttributeMultiprocessorCount, dev) != hipSuccess) { grid = -1; return; }
        if (hipFuncSetAttribute((const void*)fwd_kernel, hipFuncAttributeMaxDynamicSharedMemorySize, LDS_BYTES) != hipSuccess) { fprintf(stderr, "kernel_launch: hipFuncSetAttribute failed\n"); grid = -1; return; }
        if (hipOccupancyMaxActiveBlocksPerMultiprocessor(&per_cu, (const void*)fwd_kernel, NTHREADS, LDS_BYTES) != hipSuccess || per_cu < 1) { fprintf(stderr, "kernel_launch: occupancy query says %d\n", per_cu); per_cu = 1; }
        (void)hipGetLastError();
        grid = cus;
        if (grid > 256) grid = 256;
        fprintf(stderr, "kernel_launch: grid %d (cus %d, per_cu %d)\n", grid, cus, per_cu);
    }
    if (grid < 0) return;
#if 1
    if (hipMemsetAsync((char*)d_ws + WS_CTL, 0, CTL_ZERO_BYTES, stream) != hipSuccess) { fprintf(stderr, "kernel_launch: memset failed\n"); return; }
#endif
    Args a{};
    for (int i = 0; i < 27; ++i) a.in[i] = (const float*)d_in[i];
    a.out = (float*)d_out; a.ws = (unsigned char*)d_ws;
#if MK_N_LAUNCHES == 1
    a.ph_lo = 0; a.ph_hi = NPHASES;
    void* kargs[] = {&a};
    hipError_t e = hipLaunchCooperativeKernel((const void*)fwd_kernel, dim3(grid), dim3(NTHREADS), kargs, LDS_BYTES, stream);
    if (e != hipSuccess) fprintf(stderr, "kernel_launch: cooperative launch failed: %s\n", hipGetErrorString(e));
#else
    for (int ph = 0; ph < NPHASES; ++ph) { a.ph_lo = ph; a.ph_hi = ph + 1;
        hipLaunchKernelGGL(fwd_kernel, dim3(grid), dim3(NTHREADS), LDS_BYTES, stream, a);
        const hipError_t le = hipPeekAtLastError(); if (le != hipSuccess) { fprintf(stderr, "kernel_launch: launch %d failed: %s\n", ph, hipGetErrorName(le)); break; } }
#endif
}
```

```cpp
#include <hip/hip_runtime.h>
#include <hip/hip_cooperative_groups.h>
#include <cstdio>
#include <cstdint>
#define MK_N_LAUNCHES 1
namespace pg8 {
#define PG8_LAS __attribute__((address_space(3)))
typedef unsigned short bf16_t;
typedef short bf16x8 __attribute__((ext_vector_type(8)));
typedef float f32x4 __attribute__((ext_vector_type(4)));
typedef unsigned u32x4 __attribute__((ext_vector_type(4)));
constexpr int BM = 256, BK = 64, HALF = 128, HTB = HALF * BK * 2  , STAGE_BYTES = 8 * HTB, NXCD = 8, WGM = 8;

__host__ __device__ __forceinline__ int lds_byte(int r, int c) { const int st = (r >> 4) * 2 + (c >> 5), rr = r & 15, cc = c & 31, ob = rr * 64 + cc * 2; return st * 1024 + (ob ^ (((ob >> 9) & 1) << 5)); }
__host__ __device__ __forceinline__ void stage_rc(int b, int& R, int& C) { const int st = b / 1024, sb = b % 1024, swz = sb ^ (((sb >> 9) & 1) << 5); R = (st >> 1) * 16 + swz / 64; C = (st & 1) * 32 + (swz % 64) / 2; }
__host__ __device__ __forceinline__ int perm32(int rho) { const int n = rho >> 4, i = rho & 15; return 8 * (i >> 2) + 4 * n + (i & 3); }

struct Unit { int pm, pn; };
struct Gemm { const bf16_t* A; const bf16_t* Bt; int M, N, K; };

struct StaticOrder {
    int nM, nN, nwg, G, c;
    __host__ __device__ void init(int M, int N, int G_, int c_) { nM = M / BM; nN = N / BM; nwg = nM * nN; G = G_; c = c_; }
    __host__ __device__ bool next(int i, Unit& u) const {
        const long L = (long)i * G + c; if (L >= nwg) return false;
        int wgid = (int)L; { const int q = nwg / NXCD, r = nwg % NXCD, xcd = wgid % NXCD, off = wgid / NXCD; wgid = (xcd < r ? xcd * (q + 1) : r * (q + 1) + (xcd - r) * q) + off; }
        const int nig = WGM * nN, gid = wgid / nig, fm = gid * WGM, gsz = (nM - fm) < WGM ? (nM - fm) : WGM;
        u.pm = fm + ((wgid % nig) % gsz); u.pn = (wgid % nig) / gsz; return true;
    }
    __device__ __forceinline__ void a_ready(const Unit&) const {}
    __device__ __forceinline__ void done(const Unit&) const {}
};
__device__ __forceinline__ unsigned cvt_pk_bf16(float lo, float hi) { unsigned r; asm volatile("v_cvt_pk_bf16_f32 %0, %1, %2" : "=v"(r) : "v"(lo), "v"(hi)); return r; }
typedef float f32x2 __attribute__((ext_vector_type(2)));
__device__ __forceinline__ float sigmoidf_(float x) { return __builtin_amdgcn_rcpf(1.0f + __expf(-x)); }
__device__ __forceinline__ float gelu_tanh(float x) { const float u = 1.5957691216057308f * (x + 0.044715f * x * x * x); return x * sigmoidf_(u); }
constexpr int SEQ_SHIFT = 11;
constexpr int NMODP = 12288;

struct EpiS5U {
    static constexpr bool PERM = true, AFTER_DRAIN = false;
    bf16_t* UG;
    __device__ __forceinline__ void operator()(const f32x4 (&acc)[2][2][4][2], const Unit& u, int wr, int wc, int fr, int fq) const {
        const int row0 = u.pm * BM + wr * 64 + fr, colb = u.pn * BM + wc * 32 + 8 * fq;
#pragma unroll
        for (int ai = 0; ai < 2; ++ai)
#pragma unroll
            for (int m = 0; m < 4; ++m) { const int r = row0 + ai * HALF + m * 16, b = r >> SEQ_SHIFT, t = r & 2047;
#pragma unroll
                for (int bj = 0; bj < 2; ++bj) { const int c0 = colb + bj * HALF, g = c0 >> 4, hf = (c0 >> 3) & 1;
                    const f32x4 v0 = acc[ai][bj][m][0], v1 = acc[ai][bj][m][1];
                    u32x4 w; w.x = cvt_pk_bf16(v0[0], v0[1]); w.y = cvt_pk_bf16(v0[2], v0[3]); w.z = cvt_pk_bf16(v1[0], v1[1]); w.w = cvt_pk_bf16(v1[2], v1[3]);
                    *(u32x4*)(UG + ((size_t)(b * 128 + g) * 2048 + t) * 16 + 8 * hf) = w; } }
    }
};
struct EpiGluRes {
    static constexpr bool PERM = true, AFTER_DRAIN = false;
    const float* xin; bf16_t* xout; const float* gate;
    __device__ __forceinline__ void operator()(const f32x4 (&acc)[2][2][4][2], const Unit& u, int wr, int wc, int fr, int fq) const {
        const int row0 = u.pm * BM + wr * 64 + fr, j0 = u.pn * HALF + wc * 32 + 8 * fq;
        const float* gp = gate + (u.pm >> 3) * NMODP + j0; const f32x4 g0 = *(const f32x4*)gp, g1 = *(const f32x4*)(gp + 4);
#pragma unroll
        for (int ai = 0; ai < 2; ++ai)
#pragma unroll
            for (int m = 0; m < 4; ++m) { const int r = row0 + ai * HALF + m * 16;
                const f32x4 x0 = *(const f32x4*)(xin + (size_t)r * 2048 + j0), x1 = *(const f32x4*)(xin + (size_t)r * 2048 + j0 + 4);
                const f32x4 va0 = acc[ai][0][m][0], gt0 = acc[ai][1][m][0], va1 = acc[ai][0][m][1], gt1 = acc[ai][1][m][1]; float o[8];
#pragma unroll
                for (int i = 0; i < 4; ++i) { o[i] = x0[i] + g0[i] * (va0[i] * sigmoidf_(gt0[i])); o[4 + i] = x1[i] + g1[i] * (va1[i] * sigmoidf_(gt1[i])); }
                u32x4 w; w.x = cvt_pk_bf16(o[0], o[1]); w.y = cvt_pk_bf16(o[2], o[3]); w.z = cvt_pk_bf16(o[4], o[5]); w.w = cvt_pk_bf16(o[6], o[7]);
                *(u32x4*)(xout + (size_t)r * 2048 + j0) = w; }
    }
};
struct EpiSwiGlu {
    static constexpr bool PERM = true, AFTER_DRAIN = false;
    bf16_t* O; int ldc;
    __device__ __forceinline__ void operator()(const f32x4 (&acc)[2][2][4][2], const Unit& u, int wr, int wc, int fr, int fq) const {
        const int row0 = u.pm * BM + wr * 64 + fr, j0 = u.pn * HALF + wc * 32 + 8 * fq;
#pragma unroll
        for (int ai = 0; ai < 2; ++ai)
#pragma unroll
            for (int m = 0; m < 4; ++m) { const int r = row0 + ai * HALF + m * 16; float o[8];
#pragma unroll
                for (int n = 0; n < 2; ++n) { const f32x4 g = acc[ai][0][m][n], uu = acc[ai][1][m][n];
#pragma unroll
                    for (int i = 0; i < 4; ++i) o[4 * n + i] = g[i] * sigmoidf_(g[i]) * uu[i]; }
                u32x4 w; w.x = cvt_pk_bf16(o[0], o[1]); w.y = cvt_pk_bf16(o[2], o[3]); w.z = cvt_pk_bf16(o[4], o[5]); w.w = cvt_pk_bf16(o[6], o[7]);
                *(u32x4*)(O + (size_t)r * ldc + j0) = w; }
    }
};
__device__ __forceinline__ float bf_lo(unsigned v) { return __builtin_bit_cast(float, v << 16); }
__device__ __forceinline__ float bf_hi(unsigned v) { return __builtin_bit_cast(float, v & 0xffff0000u); }
struct EpiRes {
    static constexpr bool PERM = true, AFTER_DRAIN = false;
    const bf16_t* xin; bf16_t* xout; const float* gate;
    __device__ __forceinline__ void operator()(const f32x4 (&acc)[2][2][4][2], const Unit& u, int wr, int wc, int fr, int fq) const {
        const int row0 = u.pm * BM + wr * 64 + fr, col0 = u.pn * BM + wc * 32 + 8 * fq;
        const float* gp = gate + (u.pm >> 3) * NMODP + col0; f32x4 g[2][2];
#pragma unroll
        for (int bj = 0; bj < 2; ++bj) { g[bj][0] = *(const f32x4*)(gp + bj * HALF); g[bj][1] = *(const f32x4*)(gp + bj * HALF + 4); }
#pragma unroll
        for (int ai = 0; ai < 2; ++ai)
#pragma unroll
            for (int m = 0; m < 4; ++m) { const int r = row0 + ai * HALF + m * 16;
#pragma unroll
                for (int bj = 0; bj < 2; ++bj) { const size_t off = (size_t)r * 2048 + col0 + bj * HALF; const u32x4 xv = *(const u32x4*)(xin + off);
                    const f32x4 a0 = acc[ai][bj][m][0], a1 = acc[ai][bj][m][1]; u32x4 w;
                    w.x = cvt_pk_bf16(bf_lo(xv.x) + g[bj][0][0] * a0[0], bf_hi(xv.x) + g[bj][0][1] * a0[1]); w.y = cvt_pk_bf16(bf_lo(xv.y) + g[bj][0][2] * a0[2], bf_hi(xv.y) + g[bj][0][3] * a0[3]);
                    w.z = cvt_pk_bf16(bf_lo(xv.z) + g[bj][1][0] * a1[0], bf_hi(xv.z) + g[bj][1][1] * a1[1]); w.w = cvt_pk_bf16(bf_lo(xv.w) + g[bj][1][2] * a1[2], bf_hi(xv.w) + g[bj][1][3] * a1[3]);
                    *(u32x4*)(xout + off) = w; } }
    }
};
struct EpiLruIn {
    static constexpr bool PERM = true, AFTER_DRAIN = false;
    bf16_t* GG; bf16_t* XB;
    __device__ __forceinline__ void operator()(const f32x4 (&acc)[2][2][4][2], const Unit& u, int wr, int wc, int fr, int fq) const {
        const int row0 = u.pm * BM + wr * 64 + fr; const bool isg = u.pn < 11;
        const int colb = (isg ? u.pn : u.pn - 11) * BM + wc * 32 + 8 * fq; bf16_t* base = isg ? GG : XB;
#pragma unroll
        for (int ai = 0; ai < 2; ++ai)
#pragma unroll
            for (int m = 0; m < 4; ++m) { bf16_t* rowp = base + (size_t)(row0 + ai * HALF + m * 16) * 2816 + colb;
#pragma unroll
                for (int bj = 0; bj < 2; ++bj) { f32x4 v0 = acc[ai][bj][m][0], v1 = acc[ai][bj][m][1];
                    if (isg) {
#pragma unroll
                        for (int i = 0; i < 4; ++i) { v0[i] = gelu_tanh(v0[i]); v1[i] = gelu_tanh(v1[i]); } }
                    u32x4 w; w.x = cvt_pk_bf16(v0[0], v0[1]); w.y = cvt_pk_bf16(v0[2], v0[3]); w.z = cvt_pk_bf16(v1[0], v1[1]); w.w = cvt_pk_bf16(v1[2], v1[3]);
                    *(u32x4*)(rowp + bj * HALF) = w; } }
    }
};
template <class Epi, class Sched, bool ALIGN_EPI = false, bool SP2 = false>
__device__ __forceinline__ void gemm_phase(PG8_LAS unsigned char* lds, const Gemm g, const Sched& S, const Epi& E) {
    const int tid = threadIdx.x, wid = __builtin_amdgcn_readfirstlane(tid >> 6), lane = tid & 63, wr = wid >> 2, wc = wid & 3, fr = lane & 15, fq = lane >> 4;
    const int K = g.K, nt = K / BK;
    unsigned voffA[2], voffB[2];
#pragma unroll
    for (int i = 0; i < 2; ++i) { int R, C; stage_rc(tid * 16 + i * 8192, R, C); const int Rb = Epi::PERM ? ((R & ~31) + perm32(R & 31)) : R;
        voffA[i] = (unsigned)(R * K + C) * 2u; voffB[i] = (unsigned)(Rb * K + C) * 2u; }
    const size_t kstep = (size_t)(BK * 2);
    const size_t hstep = (size_t)HALF * K * 2;
    const size_t tstep = 2 * hstep;
    const unsigned ldsw = (unsigned)wid * 1024u;
    const int aoff = lds_byte(wr * 64 + fr, fq * 8), boff = lds_byte(wc * 32 + fr, fq * 8);
#define PG8_SA(b, h) (((b) * 2 + (h)) * HTB)
#define PG8_SB(b, h) ((4 + (b) * 2 + (h)) * HTB)
#define PG8_STAGE(bufoff, gbase, voff) do { _Pragma("unroll") for (int _i = 0; _i < 2; ++_i) \
        __builtin_amdgcn_global_load_lds((const unsigned*)((const char*)(gbase) + (voff)[_i]), (PG8_LAS unsigned*)(lds + (bufoff) + ldsw + _i * 8192), 16, 0, 0); } while (0)
#define PG8_LDA(dst, b, h) do { _Pragma("unroll") for (int m = 0; m < 4; ++m) _Pragma("unroll") for (int k = 0; k < 2; ++k) dst[m][k] = *(const PG8_LAS bf16x8*)(lds + PG8_SA(b, h) + aoff + m * 2048 + k * 1024); } while (0)
#define PG8_LDB(dst, b, h) do { _Pragma("unroll") for (int n = 0; n < 2; ++n) _Pragma("unroll") for (int k = 0; k < 2; ++k) dst[n][k] = *(const PG8_LAS bf16x8*)(lds + PG8_SB(b, h) + boff + n * 2048 + k * 1024); } while (0)
#define PG8_MMA(ai, bj, At, Bt) do { __builtin_amdgcn_s_setprio(1); _Pragma("unroll") for (int m = 0; m < 4; ++m) _Pragma("unroll") for (int n = 0; n < 2; ++n) _Pragma("unroll") for (int k = 0; k < 2; ++k) \
        acc[ai][bj][m][n] = __builtin_amdgcn_mfma_f32_16x16x32_bf16(Bt[n][k], At[m][k], acc[ai][bj][m][n], 0, 0, 0); __builtin_amdgcn_s_setprio(0); } while (0)
#define PG8_WAIT_V(n) asm volatile("s_waitcnt vmcnt(" #n ")" ::: "memory")
#define PG8_WAIT_L(n) asm volatile("s_waitcnt lgkmcnt(" #n ")" ::: "memory")
#define PG8_BAR __builtin_amdgcn_s_barrier()
#define PG8_SCHED __builtin_amdgcn_sched_barrier(0)
    Unit cur, nxt; int ui = 0;
    if (!S.next(0, cur)) return;
    f32x4 acc[2][2][4][2];
#pragma unroll
    for (int a = 0; a < 2; ++a)
#pragma unroll
        for (int b = 0; b < 2; ++b)
#pragma unroll
            for (int m = 0; m < 4; ++m)
#pragma unroll
                for (int n = 0; n < 2; ++n) acc[a][b][m][n] = (f32x4){0.f, 0.f, 0.f, 0.f};
    bf16x8 At[4][2], B0[2][2], B1[2][2];
    const char* cA = (const char*)g.A + (size_t)cur.pm * tstep; const char* cB = (const char*)g.Bt + (size_t)cur.pn * tstep;
    S.a_ready(cur);
    if constexpr (SP2) {
        PG8_STAGE(PG8_SB(0, 0), cB, voffB); PG8_STAGE(PG8_SB(0, 1), cB + hstep, voffB); PG8_STAGE(PG8_SA(0, 0), cA, voffA); PG8_STAGE(PG8_SA(0, 1), cA + hstep, voffA);
        if (wr == 1) PG8_BAR;
        PG8_WAIT_V(2); PG8_BAR;
        PG8_STAGE(PG8_SB(1, 0), cB + kstep, voffB); PG8_STAGE(PG8_SA(1, 0), cA + kstep, voffA); PG8_STAGE(PG8_SB(1, 1), cB + hstep + kstep, voffB);
        PG8_WAIT_V(6); PG8_BAR;
    } else {
        PG8_STAGE(PG8_SB(0, 0), cB, voffB); PG8_STAGE(PG8_SA(0, 0), cA, voffA); PG8_STAGE(PG8_SB(0, 1), cB + hstep, voffB); PG8_STAGE(PG8_SA(0, 1), cA + hstep, voffA);
        if (wr == 1) PG8_BAR;
        PG8_WAIT_V(4); PG8_BAR;
        PG8_STAGE(PG8_SB(1, 0), cB + kstep, voffB); PG8_STAGE(PG8_SA(1, 0), cA + kstep, voffA); PG8_STAGE(PG8_SB(1, 1), cB + hstep + kstep, voffB);
        PG8_WAIT_V(6); PG8_BAR;
    }
    for (;;) {
        const bool has_next = S.next(ui + 1, nxt);
        const char* nA = has_next ? (const char*)g.A + (size_t)nxt.pm * tstep : cA; const char* nB = has_next ? (const char*)g.Bt + (size_t)nxt.pn * tstep : cB;
        for (int t = 0; t < nt; t += 2) {
            const bool last = (t == nt - 2);
            const char* a1 = cA + (size_t)(t + 1) * kstep;
            const char* a2 = last ? nA : cA + (size_t)(t + 2) * kstep; const char* b2 = last ? nB : cB + (size_t)(t + 2) * kstep;
            const char* a3 = a2 + kstep; const char* b3 = b2 + kstep;
            if (last && has_next) S.a_ready(nxt);
            if constexpr (SP2) {
            PG8_LDB(B0, 0, 0); PG8_LDB(B1, 0, 1); PG8_SCHED; PG8_LDA(At, 0, 0); PG8_STAGE(PG8_SA(1, 1), a1 + hstep, voffA);
            PG8_WAIT_V(8); PG8_WAIT_L(0); PG8_BAR; PG8_MMA(0, 0, At, B0); PG8_MMA(0, 1, At, B1); PG8_BAR; PG8_SCHED;
            PG8_LDA(At, 0, 1); PG8_STAGE(PG8_SB(0, 0), b2, voffB); PG8_STAGE(PG8_SB(0, 1), b2 + hstep, voffB); PG8_STAGE(PG8_SA(0, 0), a2, voffA);
            PG8_WAIT_V(8); PG8_WAIT_L(0); PG8_BAR; PG8_MMA(1, 0, At, B0); PG8_MMA(1, 1, At, B1); PG8_BAR; PG8_SCHED;
            PG8_LDB(B0, 1, 0); PG8_LDB(B1, 1, 1); PG8_SCHED; PG8_LDA(At, 1, 0); PG8_STAGE(PG8_SA(0, 1), a2 + hstep, voffA);
            PG8_WAIT_V(8); PG8_WAIT_L(0); PG8_BAR; PG8_MMA(0, 0, At, B0); PG8_MMA(0, 1, At, B1); PG8_BAR; PG8_SCHED;
            PG8_LDA(At, 1, 1); PG8_STAGE(PG8_SB(1, 0), b3, voffB); PG8_STAGE(PG8_SB(1, 1), b3 + hstep, voffB); PG8_STAGE(PG8_SA(1, 0), a3, voffA);
            PG8_WAIT_V(8); PG8_WAIT_L(0); PG8_BAR; PG8_MMA(1, 0, At, B0); PG8_MMA(1, 1, At, B1); PG8_BAR; PG8_SCHED;
            } else {
            PG8_LDB(B0, 0, 0); PG8_SCHED; PG8_LDA(At, 0, 0); PG8_STAGE(PG8_SA(1, 1), a1 + hstep, voffA);
            PG8_WAIT_L(8); PG8_BAR; PG8_WAIT_L(0); PG8_MMA(0, 0, At, B0); PG8_BAR; PG8_SCHED;
            PG8_LDB(B1, 0, 1); PG8_STAGE(PG8_SB(0, 0), b2, voffB);
            PG8_BAR; PG8_WAIT_L(0); PG8_MMA(0, 1, At, B1); PG8_BAR;
            PG8_LDA(At, 0, 1); PG8_STAGE(PG8_SA(0, 0), a2, voffA);
            PG8_BAR; PG8_WAIT_L(0); PG8_MMA(1, 0, At, B0); PG8_BAR; PG8_SCHED;
            PG8_STAGE(PG8_SB(0, 1), b2 + hstep, voffB);
            PG8_WAIT_V(6); PG8_BAR; PG8_MMA(1, 1, At, B1); PG8_BAR;
            PG8_LDB(B0, 1, 0); PG8_SCHED; PG8_LDA(At, 1, 0); PG8_STAGE(PG8_SA(0, 1), a2 + hstep, voffA);
            PG8_WAIT_L(8); PG8_BAR; PG8_WAIT_L(0); PG8_MMA(0, 0, At, B0); PG8_BAR; PG8_SCHED;
            PG8_LDB(B1, 1, 1); PG8_STAGE(PG8_SB(1, 0), b3, voffB);
            PG8_BAR; PG8_WAIT_L(0); PG8_MMA(0, 1, At, B1); PG8_BAR;
            PG8_LDA(At, 1, 1); PG8_STAGE(PG8_SA(1, 0), a3, voffA);
            PG8_BAR; PG8_WAIT_L(0); PG8_MMA(1, 0, At, B0); PG8_BAR; PG8_SCHED;
            PG8_STAGE(PG8_SB(1, 1), b3 + hstep, voffB);
            PG8_WAIT_V(6); PG8_BAR; PG8_MMA(1, 1, At, B1); PG8_BAR;
            }
        }
        if constexpr (ALIGN_EPI) { if (wr == 0) PG8_BAR; }
        if constexpr (!Epi::AFTER_DRAIN) { E(acc, cur, wr, wc, fr, fq); S.done(cur); }
        if (!has_next) break;
#pragma unroll
        for (int a = 0; a < 2; ++a)
#pragma unroll
            for (int b = 0; b < 2; ++b)
#pragma unroll
                for (int m = 0; m < 4; ++m)
#pragma unroll
                    for (int n = 0; n < 2; ++n) acc[a][b][m][n] = (f32x4){0.f, 0.f, 0.f, 0.f};
        cur = nxt; cA = nA; cB = nB; ++ui;
        if constexpr (ALIGN_EPI) { if (wr == 1) PG8_BAR; }
    }
    PG8_WAIT_V(0);
    if constexpr (!ALIGN_EPI) { if (wr == 0) PG8_BAR; }
    PG8_BAR;
    if constexpr (Epi::AFTER_DRAIN) { E.fused(acc, cur, wr, wc, fr, fq, lds, wid, lane); S.done(cur); }
#undef PG8_SA
#undef PG8_SB
#undef PG8_STAGE
#undef PG8_LDA
#undef PG8_LDB
#undef PG8_MMA
#undef PG8_WAIT_V
#undef PG8_WAIT_L
#undef PG8_BAR
#undef PG8_SCHED
}
}
namespace cg = cooperative_groups;
constexpr int NWAVES = 8, NTHREADS = 512;
#ifndef MK_N_LAUNCHES
#define MK_N_LAUNCHES 1
#endif
constexpr int NPHASES = 17;
constexpr int D = 2048, BATCH = 4, SEQ = 2048, M = BATCH * SEQ, NMOD = 6 * D;
constexpr int S5G = 128, S5P = 64, LRUW = 2816, LRUB = 176, FFH = 5632;
constexpr float EPS = 1e-6f;
constexpr size_t MiB = 1u << 20;
constexpr size_t WS_CTL = 0, CTL_ZERO_BYTES = 64 * 1024;
constexpr size_t WS_MOD = 1 * MiB;
constexpr size_t WS_AT = 1 * MiB + 512 * 1024;
constexpr size_t WS_BT1 = 2 * MiB;
constexpr size_t WS_BT2 = 6 * MiB;
constexpr size_t WS_WGATE = 14 * MiB;
constexpr size_t WS_WS5IN = 20 * MiB, WS_WGLU = 28 * MiB, WS_WGU0 = 44 * MiB, WS_WGU1 = 88 * MiB, WS_WDN0 = 132 * MiB, WS_WDN1 = 154 * MiB, WS_WLIN = 176 * MiB, WS_WLOUT = 198 * MiB;
constexpr size_t WS_X = 210 * MiB, WS_H = 274 * MiB, WS_SCR = 306 * MiB;
constexpr size_t WS_UG = WS_SCR, WS_Y = WS_SCR + 32 * MiB;
constexpr size_t WS_HID = WS_SCR;
constexpr size_t WS_GG = WS_SCR, WS_XB = WS_SCR + 44 * MiB, WS_P = WS_SCR + 88 * MiB, WS_Q = WS_SCR + 132 * MiB, WS_YL = WS_XB;
constexpr size_t WS_TOTG = 16 * MiB + 512 * 1024;
constexpr size_t WS_DUMMY = WS_SCR + 176 * MiB;
constexpr size_t WS_END = WS_SCR + 176 * MiB + 64 * MiB;
constexpr int LDS_BYTES = 163840, MISC_OFF = LDS_BYTES - 256;
constexpr int CW_BAR = 1024, CW_Q0 = 64;
#ifndef USE_CG_SYNC
#define USE_CG_SYNC 0
#endif

#define GAS __attribute__((address_space(1)))
#define LAS __attribute__((address_space(3)))
typedef unsigned short bf16;
typedef unsigned v4u __attribute__((ext_vector_type(4)));
typedef unsigned v2u __attribute__((ext_vector_type(2)));
typedef float f32x4 __attribute__((ext_vector_type(4)));
typedef float f32x2 __attribute__((ext_vector_type(2)));
typedef short bf16x8 __attribute__((ext_vector_type(8)));
#define LDS_WAIT() asm volatile("s_waitcnt lgkmcnt(0)" ::: "memory")
#define LDS_BARRIER() do { asm volatile("s_waitcnt lgkmcnt(0)" ::: "memory"); __builtin_amdgcn_s_barrier(); asm volatile("" ::: "memory"); } while (0)
__device__ __forceinline__ unsigned f2bf(float f) { unsigned u = __builtin_bit_cast(unsigned, f); return (u + 0x7fffu + ((u >> 16) & 1u)) >> 16; }
__device__ __forceinline__ unsigned pk2(float lo, float hi) { return f2bf(lo) | (f2bf(hi) << 16); }
__device__ __forceinline__ float bf2f(unsigned short v) { return __builtin_bit_cast(float, (unsigned)v << 16); }
__device__ __forceinline__ float wave_sum(float v) {
#pragma unroll
    for (int o = 1; o < 64; o <<= 1) v += __shfl_xor(v, o);
    return v;
}

struct Args {
    const float* in[27]; float* out; unsigned char* ws; int ph_lo, ph_hi;
};
enum { I_X = 0, I_C, I_NORMG, I_WADA, I_BADA, I_S5WIN, I_S5LRE, I_S5LIM, I_S5LDT, I_S5BRE, I_S5BIM, I_S5CRE, I_S5CIM, I_S5D, I_S5WGLU,
       I_LWIN, I_LCW, I_LCB, I_LWRG, I_LBRG, I_LWIG, I_LBIG, I_LLAM, I_LWOUT, I_FGU, I_FDN, I_FINALG };

struct Frame {
    LAS unsigned char* lds;
    int tid, lane, wave, vcu, G;
};

template <int MODE> __device__ __forceinline__ int srcmap(int n0, int F) {
    if (MODE == 0) return n0;
    const int pn = n0 >> 8, cl = n0 & 255; return cl < 128 ? 128 * pn + cl : F + 128 * pn + (cl - 128);
}
template <int MODE> __device__ __forceinline__ void p0_transpose_item(const float* W, int K, int N, int F, bf16* WT, LAS float* scr, int item, int lane) {
    const int nblk = N / 32, kb = item / nblk, nb = item % nblk, k0 = 64 * kb, n0 = 32 * nb, s0 = srcmap<MODE>(n0, F);
    float v[32];
    const float* wp = W + (size_t)(k0 + (lane >> 5)) * N + s0 + (lane & 31);
#pragma unroll
    for (int i = 0; i < 32; ++i) v[i] = wp[(size_t)(2 * i) * N];
#pragma unroll
    for (int i = 0; i < 32; ++i) scr[(2 * i + (lane >> 5)) * 33 + (lane & 31)] = v[i];
    LDS_WAIT(); asm volatile("" ::: "memory");
    const int c = lane & 7;
#pragma unroll
    for (int j = 0; j < 4; ++j) { const int n = (lane >> 3) + 8 * j; const LAS float* s = scr + (8 * c) * 33 + n;
        v4u o; o.x = pk2(s[0 * 33], s[1 * 33]); o.y = pk2(s[2 * 33], s[3 * 33]); o.z = pk2(s[4 * 33], s[5 * 33]); o.w = pk2(s[6 * 33], s[7 * 33]);
        *(GAS v4u*)(WT + (size_t)(n0 + n) * K + k0 + 8 * c) = o; }
    LDS_WAIT(); asm volatile("" ::: "memory");
}

__device__ __forceinline__ void p0_mod_item(const Frame& F, const Args& a, int item) {
    LAS float* cond = (LAS float*)F.lds;
    LAS float* red = (LAS float*)(F.lds + 32768);
    const int layer = item / 96, n0 = (item % 96) * 128;
    const float* c = a.in[I_C];
    for (int i = F.tid; i < 4 * D; i += NTHREADS) { const int b = i >> 11, k = i & 2047; const float v = c[i]; cond[k * 4 + b] = v / (1.0f + __expf(-v)); }
    __syncthreads();
    const float* W = a.in[I_WADA] + (size_t)layer * D * NMOD + n0 + 2 * F.lane;
    float acc[4][2] = {};
    const int kbeg = F.wave * 256;
#pragma unroll 16
    for (int k = kbeg; k < kbeg + 256; ++k) {
        const f32x2 w = *(const f32x2*)(W + (size_t)k * NMOD); const f32x4 cv = *(const LAS f32x4*)(cond + k * 4);
#pragma unroll
        for (int b = 0; b < 4; ++b) { acc[b][0] += cv[b] * w.x; acc[b][1] += cv[b] * w.y; }
    }
#pragma unroll
    for (int b = 0; b < 4; ++b) { red[(F.wave * 4 + b) * 128 + 2 * F.lane] = acc[b][0]; red[(F.wave * 4 + b) * 128 + 2 * F.lane + 1] = acc[b][1]; }
    __syncthreads();
    { const int b = F.tid >> 7, n = F.tid & 127; float s = a.in[I_BADA][layer * NMOD + n0 + n];
#pragma unroll
      for (int w = 0; w < 8; ++w) s += red[(w * 4 + b) * 128 + n];
      ((float*)(a.ws + WS_MOD))[(layer * 4 + b) * NMOD + n0 + n] = s; }
    __syncthreads();
}

__device__ __forceinline__ void p0_wgate_item(const Frame& F, const Args& a, int item) {
    const int h = item >> 1, gate = item & 1; bf16* dst = (bf16*)(a.ws + WS_WGATE) + (size_t)item * 176 * 192; const float* W = gate ? a.in[I_LWIG] : a.in[I_LWRG];
    for (int i = F.tid; i < 176 * 192; i += NTHREADS) { const int n = i / 192, k = i % 192; float v = 0.f; if (k < 176) v = W[((size_t)h * 176 + k) * 176 + n]; dst[i] = (bf16)f2bf(v); }
}

__device__ __forceinline__ void p0_s5prep_item(const Frame& F, const Args& a, int g) {
    LAS float* apr = (LAS float*)F.lds;
    LAS float* api = apr + 9 * 64;
    LAS float* bbr = api + 9 * 64;
    LAS float* bbi = bbr + 1024;
    LAS float* ccr = bbi + 1024;
    LAS float* cci = ccr + 1024;
    LAS float* fre = cci + 1024;
    LAS float* fim = fre + 64;
    LAS float* ktab = fim + 64;
    const int tid = F.tid;
    if (tid < 64) { const int p = tid; const float lr = a.in[I_S5LRE][g * 64 + p], li = a.in[I_S5LIM][g * 64 + p], dt = expf(a.in[I_S5LDT][g]);
        const float mag = expf(lr * dt), ang = li * dt, abr = mag * cosf(ang), abi = mag * sinf(ang), nr = abr - 1.0f, ni = abi, den = lr * lr + li * li;
        fre[p] = (nr * lr + ni * li) / den; fim[p] = (ni * lr - nr * li) / den;
        float pr = 1.f, pi = 0.f;
        for (int k = 0; k < 9; ++k) { apr[k * 64 + p] = pr; api[k * 64 + p] = pi; const float t = pr * abr - pi * abi; pi = pr * abi + pi * abr; pr = t; }
        float* at = (float*)(a.ws + WS_AT) + (g * 64 + p) * 2; at[0] = apr[8 * 64 + p]; at[1] = api[8 * 64 + p]; }
    __syncthreads();
    for (int i = tid; i < 1024; i += NTHREADS) { const int p = i >> 4; const float br = a.in[I_S5BRE][(size_t)g * 1024 + i], bi = a.in[I_S5BIM][(size_t)g * 1024 + i];
        bbr[i] = fre[p] * br - fim[p] * bi; bbi[i] = fre[p] * bi + fim[p] * br;
        ccr[i] = a.in[I_S5CRE][(size_t)g * 1024 + i]; cci[i] = a.in[I_S5CIM][(size_t)g * 1024 + i]; }
    __syncthreads();
    for (int i = tid; i < 2048; i += NTHREADS) { const int d = i >> 8, co = (i >> 4) & 15, ci = i & 15; float s = 0.f;
        for (int p = 0; p < 64; ++p) { const float cr = ccr[co * 64 + p], cim = cci[co * 64 + p], ar = apr[d * 64 + p], ai = api[d * 64 + p];
            const float er = cr * ar - cim * ai, ei = cr * ai + cim * ar; s += er * bbr[p * 16 + ci] - ei * bbi[p * 16 + ci]; }
        ktab[i] = s; }
    __syncthreads();
    { unsigned* dst = (unsigned*)((bf16*)(a.ws + WS_BT1) + (size_t)g * 128 * 128);
      for (int i = tid; i < 128 * 64; i += NTHREADS) { const int n = i >> 6, k = (i & 63) * 2, p = n & 63, im = n >> 6, t = k >> 4, c = k & 15;
          const float ar = apr[(7 - t) * 64 + p], ai = api[(7 - t) * 64 + p]; float v[2];
#pragma unroll
          for (int e = 0; e < 2; ++e) { const float br = bbr[p * 16 + c + e], bi = bbi[p * 16 + c + e]; v[e] = im ? (ar * bi + ai * br) : (ar * br - ai * bi); }
          dst[i] = pk2(v[0], v[1]); } }
    { unsigned* dst = (unsigned*)((bf16*)(a.ws + WS_BT2) + (size_t)g * 128 * 256);
      for (int i = tid; i < 128 * 128; i += NTHREADS) { const int n = i >> 7, k = (i & 127) * 2, to = n >> 4, co = n & 15; float v[2];
#pragma unroll
          for (int e = 0; e < 2; ++e) { const int kk = k + e; float x;
              if (kk < 128) { const int s = kk >> 4, ci = kk & 15, d = to - s; x = d >= 0 ? ktab[(d * 16 + co) * 16 + ci] : 0.f; if (d == 0 && ci == co) x += a.in[I_S5D][g * 16 + co]; }
              else { const int k2 = kk - 128, p = k2 & 63, im = k2 >> 6; const float cr = ccr[co * 64 + p], cim = cci[co * 64 + p], ar = apr[(to + 1) * 64 + p], ai = api[(to + 1) * 64 + p];
                  x = im ? -(cr * ai + cim * ar) : (cr * ar - cim * ai); }
              v[e] = x; }
          dst[i] = pk2(v[0], v[1]); } }
    __syncthreads();
}

__device__ __forceinline__ void p0_prologue(const Frame& F, const Args& a) {
    for (int it = F.vcu; it < 192 + 128 + 32; it += F.G) {
        if (it < 192) p0_mod_item(F, a, it);
        else if (it < 320) p0_s5prep_item(F, a, it - 192);
        else p0_wgate_item(F, a, it - 320);
    }
    __syncthreads();
    LAS float* scr = (LAS float*)(F.lds + F.wave * 16384);
    const int gw = F.vcu * NWAVES + F.wave, NGW = F.G * NWAVES;
    constexpr int I1 = (D / 64) * (D / 32), I2 = (D / 64) * (2 * D / 32), I3 = (D / 64) * (2 * FFH / 32), I4 = (FFH / 64) * (D / 32), I5 = (D / 64) * (2 * LRUW / 32), I6 = (LRUW / 64) * (D / 32);
    constexpr int NITEMS = I1 + I2 + 2 * I3 + 2 * I4 + I5 + I6;
    unsigned char* ws = a.ws;
    for (int it = gw; it < NITEMS; it += NGW) {
        int r = it;
        if (r < I1) { p0_transpose_item<0>(a.in[I_S5WIN], D, D, 0, (bf16*)(ws + WS_WS5IN), scr, r, F.lane); continue; } r -= I1;
        if (r < I2) { p0_transpose_item<1>(a.in[I_S5WGLU], D, 2 * D, D, (bf16*)(ws + WS_WGLU), scr, r, F.lane); continue; } r -= I2;
        if (r < I3) { p0_transpose_item<1>(a.in[I_FGU], D, 2 * FFH, FFH, (bf16*)(ws + WS_WGU0), scr, r, F.lane); continue; } r -= I3;
        if (r < I3) { p0_transpose_item<1>(a.in[I_FGU] + (size_t)D * 2 * FFH, D, 2 * FFH, FFH, (bf16*)(ws + WS_WGU1), scr, r, F.lane); continue; } r -= I3;
        if (r < I4) { p0_transpose_item<0>(a.in[I_FDN], FFH, D, 0, (bf16*)(ws + WS_WDN0), scr, r, F.lane); continue; } r -= I4;
        if (r < I4) { p0_transpose_item<0>(a.in[I_FDN] + (size_t)FFH * D, FFH, D, 0, (bf16*)(ws + WS_WDN1), scr, r, F.lane); continue; } r -= I4;
        if (r < I5) { p0_transpose_item<0>(a.in[I_LWIN], D, 2 * LRUW, 0, (bf16*)(ws + WS_WLIN), scr, r, F.lane); continue; } r -= I5;
        p0_transpose_item<0>(a.in[I_LWOUT], LRUW, D, 0, (bf16*)(ws + WS_WLOUT), scr, r, F.lane);
    }
}

__device__ __forceinline__ void load_row(const float* x, int r, int lane, f32x4 (&v)[8]) { const f32x4* xr = (const f32x4*)(x + (size_t)r * D) + lane;
#pragma unroll
    for (int j = 0; j < 8; ++j) v[j] = xr[64 * j]; }
__device__ __forceinline__ void load_row(const bf16* x, int r, int lane, f32x4 (&v)[8]) { const v2u* xr = (const v2u*)(x + (size_t)r * D) + lane;
#pragma unroll
    for (int j = 0; j < 8; ++j) { const v2u w = xr[64 * j]; v[j] = (f32x4){pg8::bf_lo(w.x), pg8::bf_hi(w.x), pg8::bf_lo(w.y), pg8::bf_hi(w.y)}; } }
template <class XT> __device__ __forceinline__ void norm_phase(const Frame& F, const XT* x, const float* gain, const float* sh, const float* sc, bf16* H) {
    const int gw = F.vcu * NWAVES + F.wave, NGW = F.G * NWAVES;
    for (int r0 = gw * 4; r0 < M; r0 += NGW * 4) {
        const int b = r0 >> 11;
        f32x4 mul[8], add[8];
#pragma unroll
        for (int j = 0; j < 8; ++j) { const int k = 256 * j + 4 * F.lane; const f32x4 g = *(const f32x4*)(gain + k), s = *(const f32x4*)(sc + b * NMOD + k); mul[j] = g * (1.0f + s); add[j] = *(const f32x4*)(sh + b * NMOD + k); }
        for (int rr = 0; rr < 4; ++rr) { const int r = r0 + rr; f32x4 v[8]; float s = 0.f; load_row(x, r, F.lane, v);
#pragma unroll
            for (int j = 0; j < 8; ++j) s += (v[j].x * v[j].x + v[j].y * v[j].y) + (v[j].z * v[j].z + v[j].w * v[j].w);
            const float rstd = 1.0f / sqrtf(wave_sum(s) * (1.0f / D) + EPS);
            v2u* o = (v2u*)(H + (size_t)r * D) + F.lane;
#pragma unroll
            for (int j = 0; j < 8; ++j) { const f32x4 y = v[j] * rstd * mul[j] + add[j]; v2u w; w.x = pk2(y.x, y.y); w.y = pk2(y.z, y.w); o[64 * j] = w; } }
    }
}
__device__ __forceinline__ void final_norm_phase(const Frame& F, const bf16* x, const float* gain, float* out) {
    const int gw = F.vcu * NWAVES + F.wave, NGW = F.G * NWAVES;
    for (int r = gw; r < M; r += NGW) { f32x4 v[8]; float s = 0.f; load_row(x, r, F.lane, v);
#pragma unroll
        for (int j = 0; j < 8; ++j) s += (v[j].x * v[j].x + v[j].y * v[j].y) + (v[j].z * v[j].z + v[j].w * v[j].w);
        const float rstd = 1.0f / sqrtf(wave_sum(s) * (1.0f / D) + EPS);
        f32x4* o = (f32x4*)(out + (size_t)r * D) + F.lane;
#pragma unroll
        for (int j = 0; j < 8; ++j) o[64 * j] = v[j] * rstd * *(const f32x4*)(gain + 256 * j + 4 * F.lane); }
}

constexpr int S5_UP = 272, S5_SP = 528, S5_SOFF = 128 * S5_UP;
__device__ __forceinline__ void s5_item(const Frame& F, const Args& a, int item) {
    const int b = item >> 7, g = item & 127, w = F.wave, lane = F.lane, fr = lane & 15, fq = lane >> 4;
    LAS unsigned char* Uc = F.lds; LAS unsigned char* S = F.lds + S5_SOFF;
    const bf16* Bt1 = (const bf16*)(a.ws + WS_BT1) + (size_t)g * 128 * 128; const bf16* Bt2 = (const bf16*)(a.ws + WS_BT2) + (size_t)g * 128 * 256;
    bf16x8 B1[4], B2[8];
#pragma unroll
    for (int kk = 0; kk < 4; ++kk) B1[kk] = *(const bf16x8*)(Bt1 + (16 * w + fr) * 128 + 32 * kk + 8 * fq);
#pragma unroll
    for (int kk = 0; kk < 8; ++kk) B2[kk] = *(const bf16x8*)(Bt2 + (16 * w + fr) * 256 + 32 * kk + 8 * fq);
    float aTr = 0.f, aTi = 0.f, sr = 0.f, si = 0.f;
    if (w == 0) { const float* at = (const float*)(a.ws + WS_AT) + (g * 64 + lane) * 2; aTr = at[0]; aTi = at[1]; }
    const bf16* UG = (const bf16*)(a.ws + WS_UG) + (size_t)(b * 128 + g) * 2048 * 16;
    bf16* Y = (bf16*)(a.ws + WS_Y);
    for (int hf = 0; hf < 2; ++hf) {
        const v4u* src = (const v4u*)(UG + (size_t)hf * 1024 * 16);
#pragma unroll
        for (int i = 0; i < 4; ++i) { const int piece = F.tid + 512 * i, row = piece >> 4, c16 = piece & 15; *(LAS v4u*)(Uc + row * S5_UP + c16 * 16) = src[piece]; }
        LDS_BARRIER();
#pragma unroll 2
        for (int mt = 0; mt < 8; ++mt) { f32x4 acc = {0.f, 0.f, 0.f, 0.f};
#pragma unroll
            for (int kk = 0; kk < 4; ++kk) { const bf16x8 av = *(const LAS bf16x8*)(Uc + (16 * mt + fr) * S5_UP + (32 * kk + 8 * fq) * 2); acc = __builtin_amdgcn_mfma_f32_16x16x32_bf16(B1[kk], av, acc, 0, 0, 0); }
            *(LAS f32x4*)(S + (16 * mt + fr) * S5_SP + (16 * w + 4 * fq) * 4) = acc; }
        LDS_BARRIER();
        if (w == 0) {
            for (int j0 = 0; j0 < 128; j0 += 8) { float er[8], ei[8];
#pragma unroll
                for (int q = 0; q < 8; ++q) { LAS unsigned char* row = S + (j0 + q) * S5_SP; er[q] = *(const LAS float*)(row + 4 * lane); ei[q] = *(const LAS float*)(row + 256 + 4 * lane); }
                asm volatile("s_waitcnt lgkmcnt(0)" ::: "memory");
#pragma unroll
                for (int q = 0; q < 8; ++q) { LAS unsigned char* row = S + (j0 + q) * S5_SP;
                    *(LAS bf16*)(row + 2 * lane) = (bf16)f2bf(sr); *(LAS bf16*)(row + 128 + 2 * lane) = (bf16)f2bf(si);
                    const float nr = aTr * sr - aTi * si + er[q], ni = aTr * si + aTi * sr + ei[q]; sr = nr; si = ni; } }
        }
        LDS_BARRIER();
#pragma unroll 2
        for (int mt = 0; mt < 8; ++mt) { f32x4 acc = {0.f, 0.f, 0.f, 0.f};
#pragma unroll
            for (int kk = 0; kk < 4; ++kk) { const bf16x8 av = *(const LAS bf16x8*)(Uc + (16 * mt + fr) * S5_UP + (32 * kk + 8 * fq) * 2); acc = __builtin_amdgcn_mfma_f32_16x16x32_bf16(B2[kk], av, acc, 0, 0, 0); }
#pragma unroll
            for (int kk = 0; kk < 4; ++kk) { const bf16x8 av = *(const LAS bf16x8*)(S + (16 * mt + fr) * S5_SP + (32 * kk + 8 * fq) * 2); acc = __builtin_amdgcn_mfma_f32_16x16x32_bf16(B2[4 + kk], av, acc, 0, 0, 0); }
            const int tok = b * 2048 + hf * 1024 + 8 * (16 * mt + fr) + w;
            v2u o; o.x = pk2(pg8::gelu_tanh(acc[0]), pg8::gelu_tanh(acc[1])); o.y = pk2(pg8::gelu_tanh(acc[2]), pg8::gelu_tanh(acc[3]));
            *(v2u*)(Y + (size_t)tok * D + 16 * g + 4 * fq) = o; }
        LDS_BARRIER();
    }
}

#ifdef PROBE_TS
#define TREG_B() const unsigned _tb = (unsigned)__builtin_amdgcn_s_memrealtime()
#define TREG_E(j) do { if (F.vcu == 0 && F.tid == 0) ((volatile LAS unsigned*)(F.lds + MISC_OFF))[40 + (j)] += (unsigned)__builtin_amdgcn_s_memrealtime() - _tb; } while (0)
#else
#define TREG_B() do {} while (0)
#define TREG_E(j) do {} while (0)
#endif
constexpr int L_AP = 400, L_ABUF = 128 * L_AP, L_SP = 352, L_PS = L_ABUF, L_QS = L_PS + 128 * L_SP, L_CONST = L_QS + 128 * L_SP, L_CWL = L_CONST + 176 * 16;
static_assert(L_CWL + 5 * 176 * 4 <= MISC_OFF, "LRU LDS map");
template <int CTRL> __device__ __forceinline__ float dpp_f(float old, float src) { return __builtin_bit_cast(float, __builtin_amdgcn_update_dpp(__builtin_bit_cast(int, old), __builtin_bit_cast(int, src), CTRL, 0xf, 0xf, false)); }
__device__ __forceinline__ void lruA_phase(const Frame& F, const Args& a) {
    const int w = F.wave, lane = F.lane, fr = lane & 15, fq = lane >> 4, tid = F.tid;
    const int h = F.vcu & 15;
    LAS float* CONST = (LAS float*)(F.lds + L_CONST);
    for (int i = tid; i < 176; i += NTHREADS) { const int ch = 176 * h + i; const float lam = a.in[I_LLAM][ch]; const float sp = lam < -20.f ? -lam : log1pf(expf(-lam));
        CONST[4 * i] = -8.0f * sp; CONST[4 * i + 1] = a.in[I_LBRG][ch]; CONST[4 * i + 2] = a.in[I_LBIG][ch]; CONST[4 * i + 3] = 0.f; }
    for (int i = tid; i < 128 * 2; i += NTHREADS) { const int row = i >> 1, c16 = i & 1; *(LAS v4u*)(F.lds + row * L_AP + 352 + c16 * 16) = (v4u){0u, 0u, 0u, 0u}; }
    const int quad = tid % 44, rg8 = tid / 44;
    LAS float* CWL = (LAS float*)(F.lds + L_CWL);
    for (int i = tid; i < 5 * 176; i += NTHREADS) { const int k = i / 176, ch = i % 176; CWL[i] = k < 4 ? a.in[I_LCW][k * LRUW + 176 * h + ch] : a.in[I_LCB][176 * h + ch]; }
    const bf16* XB = (const bf16*)(a.ws + WS_XB); const bf16* GG = (const bf16*)(a.ws + WS_GG); bf16* PB = (bf16*)(a.ws + WS_P); bf16* QB = (bf16*)(a.ws + WS_Q);
    f32x2* TOTG = (f32x2*)(a.ws + WS_TOTG);
    const bf16* WG2 = (const bf16*)(a.ws + WS_WGATE) + (size_t)h * 2 * 176 * 192;
    const int mg = w >> 2, cs = w & 3, ct0 = 3 * cs, ct1 = cs < 3 ? ct0 + 3 : 11;
    v2u raw[19]; bf16x8 wr[6], wi[6]; v2u ggn[4];
#define LRU_LOAD_RAW(ITEM) do { const int tix_ = (ITEM) >> 4, b_ = tix_ >> 4, tb_ = (tix_ & 15) * 128 + 16 * rg8; \
        const bf16* src_ = XB + (size_t)(b_ * 2048 + tb_ - 3) * LRUW + 176 * h + 4 * quad; \
        _Pragma("unroll") for (int r = 0; r < 19; ++r) { raw[r] = (v2u){0u, 0u}; if (tb_ - 3 + r >= 0) raw[r] = *(const v2u*)(src_ + (size_t)r * LRUW); } } while (0)
#define LRU_CONV(ABUF) do { f32x4 cw[4]; _Pragma("unroll") for (int k = 0; k < 4; ++k) cw[k] = *(const LAS f32x4*)(CWL + k * 176 + 4 * quad); const f32x4 cb = *(const LAS f32x4*)(CWL + 4 * 176 + 4 * quad); \
        _Pragma("unroll") for (int r = 0; r < 16; ++r) { float o[4] = {cb[0], cb[1], cb[2], cb[3]}; \
            _Pragma("unroll") for (int k = 0; k < 4; ++k) { const v2u v = raw[r + k]; \
                o[0] += cw[k][0] * bf2f((unsigned short)(v.x & 0xffffu)); o[1] += cw[k][1] * bf2f((unsigned short)(v.x >> 16)); \
                o[2] += cw[k][2] * bf2f((unsigned short)(v.y & 0xffffu)); o[3] += cw[k][3] * bf2f((unsigned short)(v.y >> 16)); } \
            v2u ov; ov.x = pk2(o[0], o[1]); ov.y = pk2(o[2], o[3]); *(LAS v2u*)((ABUF) + (16 * rg8 + r) * L_AP + quad * 8) = ov; } } while (0)
#define LRU_LOAD_W(CT) do { _Pragma("unroll") for (int kk = 0; kk < 6; ++kk) { wr[kk] = *(const bf16x8*)(WG2 + (size_t)(16 * (CT) + fr) * 192 + 32 * kk + 8 * fq); \
            wi[kk] = *(const bf16x8*)(WG2 + (size_t)(176 + 16 * (CT) + fr) * 192 + 32 * kk + 8 * fq); } } while (0)
#define LRU_LOAD_GG(ITEM, CT) do { const int tix_ = (ITEM) >> 4; const size_t tokb_ = (size_t)((tix_ >> 4) * 2048 + (tix_ & 15) * 128 + 64 * mg + fr); \
        _Pragma("unroll") for (int mt = 0; mt < 4; ++mt) ggn[mt] = *(const v2u*)(GG + (tokb_ + 16 * mt) * LRUW + 176 * h + 16 * (CT) + 4 * fq); } while (0)
    __syncthreads();
    if (tid < 352) { LRU_LOAD_RAW(F.vcu); LRU_CONV(F.lds); }
    LRU_LOAD_W(ct0); LRU_LOAD_GG(F.vcu, ct0);
    __syncthreads();
    int it_n = 0;
    for (int item = F.vcu; item < 1024; item += F.G, ++it_n) {
        const int tix = item >> 4, b = tix >> 4, tile = tix & 15, t0 = tile * 128;
        const int nitem = item + F.G; const bool has_next = nitem < 1024;
        LAS unsigned char* A = F.lds;
        if (has_next && tid < 352) LRU_LOAD_RAW(nitem);
        const int chunk = tile * 2 + mg;
        { TREG_B();
        for (int ct = ct0; ct < ct1; ++ct) {
            const size_t tokb = (size_t)(b * 2048 + t0 + 64 * mg + fr);
            const int chb = 176 * h + 16 * ct + 4 * fq;
            v2u ggr[4];
#pragma unroll
            for (int mt = 0; mt < 4; ++mt) ggr[mt] = ggn[mt];
            f32x4 ar[4], ai[4];
#pragma unroll
            for (int mt = 0; mt < 4; ++mt) { ar[mt] = (f32x4){0.f, 0.f, 0.f, 0.f}; ai[mt] = (f32x4){0.f, 0.f, 0.f, 0.f}; }
#pragma unroll
            for (int kk = 0; kk < 6; ++kk)
#pragma unroll
                for (int mt = 0; mt < 4; ++mt) { const bf16x8 av = *(const LAS bf16x8*)(A + (64 * mg + 16 * mt + fr) * L_AP + (32 * kk + 8 * fq) * 2);
                    ar[mt] = __builtin_amdgcn_mfma_f32_16x16x32_bf16(wr[kk], av, ar[mt], 0, 0, 0); ai[mt] = __builtin_amdgcn_mfma_f32_16x16x32_bf16(wi[kk], av, ai[mt], 0, 0, 0); }
            { const bool more = ct + 1 < ct1; const int nct = more ? ct + 1 : ct0;
              asm volatile("" : "+v"(ar[3]), "+v"(ai[3]));
              LRU_LOAD_W(nct); if (more) LRU_LOAD_GG(item, nct); else if (has_next) LRU_LOAD_GG(nitem, nct); }
            f32x4 cst[4];
#pragma unroll
            for (int i = 0; i < 4; ++i) cst[i] = *(const LAS f32x4*)(CONST + 4 * (16 * ct + 4 * fq + i));
            float Ac[4] = {1.f, 1.f, 1.f, 1.f}, Bc[4] = {0.f, 0.f, 0.f, 0.f};
#pragma unroll
            for (int mt = 0; mt < 4; ++mt) {
                const v2u xr = *(const LAS v2u*)(A + (64 * mg + 16 * mt + fr) * L_AP + (16 * ct + 4 * fq) * 2);
                const float xc[4] = {bf2f((unsigned short)(xr.x & 0xffffu)), bf2f((unsigned short)(xr.x >> 16)), bf2f((unsigned short)(xr.y & 0xffffu)), bf2f((unsigned short)(xr.y >> 16))};
                const float gg[4] = {bf2f((unsigned short)(ggr[mt].x & 0xffffu)), bf2f((unsigned short)(ggr[mt].x >> 16)), bf2f((unsigned short)(ggr[mt].y & 0xffffu)), bf2f((unsigned short)(ggr[mt].y >> 16))};
                float P4[4], Q4[4], av[4], bv[4];
#pragma unroll
                for (int i = 0; i < 4; ++i) {
                    const float r = pg8::sigmoidf_(ar[mt][i] + cst[i].y), ig = pg8::sigmoidf_(ai[mt][i] + cst[i].z);
                    const float la = cst[i].x * r, x2 = 2.0f * la;
                    av[i] = __expf(la);
                    const float em1 = x2 * (1.0f + x2 * (0.5f + x2 * (0.16666667f + x2 * (0.041666668f + x2 * 0.0083333338f))));
                    bv[i] = __builtin_amdgcn_sqrtf(-em1) * ig * xc[i];
                }
#define LRU_DPP_STEP(S) \
                    "v_fmac_f32_dpp %4, %4, %0 row_shr:" #S " row_mask:0xf bank_mask:0xf\n\t" "v_fmac_f32_dpp %5, %5, %1 row_shr:" #S " row_mask:0xf bank_mask:0xf\n\t" \
                    "v_fmac_f32_dpp %6, %6, %2 row_shr:" #S " row_mask:0xf bank_mask:0xf\n\t" "v_fmac_f32_dpp %7, %7, %3 row_shr:" #S " row_mask:0xf bank_mask:0xf\n\t" \
                    "v_mul_f32_dpp %0, %0, %0 row_shr:" #S " row_mask:0xf bank_mask:0xf\n\t" "v_mul_f32_dpp %1, %1, %1 row_shr:" #S " row_mask:0xf bank_mask:0xf\n\t" \
                    "v_mul_f32_dpp %2, %2, %2 row_shr:" #S " row_mask:0xf bank_mask:0xf\n\t" "v_mul_f32_dpp %3, %3, %3 row_shr:" #S " row_mask:0xf bank_mask:0xf\n\t"
                asm volatile("s_nop 1\n\t" LRU_DPP_STEP(1) LRU_DPP_STEP(2) LRU_DPP_STEP(4) LRU_DPP_STEP(8) "s_nop 1"
                             : "+v"(av[0]), "+v"(av[1]), "+v"(av[2]), "+v"(av[3]), "+v"(bv[0]), "+v"(bv[1]), "+v"(bv[2]), "+v"(bv[3]));
#undef LRU_DPP_STEP
#pragma unroll
                for (int i = 0; i < 4; ++i) {
                    const float hl = bv[i] + av[i] * Bc[i], ca = av[i] * Ac[i];
                    Ac[i] = __shfl(ca, 15, 16); Bc[i] = __shfl(hl, 15, 16);
                    P4[i] = hl * gg[i]; Q4[i] = ca * gg[i];
                }
                v2u po, qo; po.x = pk2(P4[0], P4[1]); po.y = pk2(P4[2], P4[3]); qo.x = pk2(Q4[0], Q4[1]); qo.y = pk2(Q4[2], Q4[3]);
                const int so = (64 * mg + 16 * mt + fr) * L_SP + (16 * ct + 4 * fq) * 2;
                *(LAS v2u*)(F.lds + L_PS + so) = po; *(LAS v2u*)(F.lds + L_QS + so) = qo;
            }
            if (fr == 15) {
#pragma unroll
                for (int i = 0; i < 4; ++i) TOTG[(size_t)(b * 32 + chunk) * LRUW + chb + i] = (f32x2){Ac[i], Bc[i]}; }
        }
        TREG_E(0); }
        { TREG_B(); LDS_BARRIER(); TREG_E(1); }
        { TREG_B();
        if (has_next && tid < 352) LRU_CONV(F.lds);
#pragma unroll
        for (int j = 0; j < 11; ++j) { const int p = tid + NTHREADS * j, which = p >= 2816, pp = which ? p - 2816 : p, row = pp / 22, c16 = pp % 22;
            const v4u v = *(const LAS v4u*)(F.lds + (which ? L_QS : L_PS) + row * L_SP + c16 * 16);
            *(v4u*)((which ? QB : PB) + (size_t)(b * 2048 + t0 + row) * LRUW + 176 * h + 8 * c16) = v; }
        TREG_E(2); }
        { TREG_B(); LDS_BARRIER(); TREG_E(3); }
    }
#undef LRU_LOAD_RAW
#undef LRU_CONV
#undef LRU_LOAD_W
#undef LRU_LOAD_GG
}
__device__ __forceinline__ void lruB_phase(const Frame& F, const Args& a) {
    const bf16* PB = (const bf16*)(a.ws + WS_P); const bf16* QB = (const bf16*)(a.ws + WS_Q); bf16* YL = (bf16*)(a.ws + WS_YL);
    const f32x4* TOTG = (const f32x4*)(a.ws + WS_TOTG);
    const int NIT = BATCH * 32 * 2 * 352, gt = F.vcu * NTHREADS + F.tid, NT = F.G * NTHREADS;
    for (int it = gt; it < NIT; it += NT) {
        const int cg = it % 352, r1 = it / 352, tq = r1 & 1, r2 = r1 >> 1, chunk = r2 & 31, b = r2 >> 5;
        float hin[8] = {0.f, 0.f, 0.f, 0.f, 0.f, 0.f, 0.f, 0.f};
        for (int jj = 0; jj < chunk; ++jj) { const f32x4* t = TOTG + ((size_t)(b * 32 + jj) * LRUW + 8 * cg) / 2;
#pragma unroll
            for (int e = 0; e < 4; ++e) { const f32x4 v = t[e]; hin[2 * e] = v.x * hin[2 * e] + v.y; hin[2 * e + 1] = v.z * hin[2 * e + 1] + v.w; } }
        const size_t base = (size_t)(b * 2048 + chunk * 64 + tq * 32) * LRUW + 8 * cg;
#pragma unroll 8
        for (int tt = 0; tt < 32; ++tt) { const v4u p = *(const v4u*)(PB + base + (size_t)tt * LRUW), q = *(const v4u*)(QB + base + (size_t)tt * LRUW); v4u o;
#pragma unroll
            for (int e = 0; e < 4; ++e) { const unsigned pw = p[e], qw = q[e];
                const float y0 = bf2f((unsigned short)(pw & 0xffffu)) + bf2f((unsigned short)(qw & 0xffffu)) * hin[2 * e], y1 = bf2f((unsigned short)(pw >> 16)) + bf2f((unsigned short)(qw >> 16)) * hin[2 * e + 1];
                o[e] = pk2(y0, y1); }
            *(v4u*)(YL + base + (size_t)tt * LRUW) = o; }
    }
}
#define XB_TMO      128
#define XB_XCNT(j)  (256  + 64 * (j))
#define XB_XSUB(j)  (1280 + 64 * (j))
#define XB_XGEN(j)  (2304 + 64 * (j))
#define XB_TOP      3328
#define XB_TOPGEN   3392
#define XCD_BAR_WORDS 3456
#define XB_SPIN_CAP (1u << 18)

__device__ __forceinline__ unsigned xb_ld(unsigned* p)              { return __hip_atomic_load(p, __ATOMIC_RELAXED, __HIP_MEMORY_SCOPE_AGENT); }
__device__ __forceinline__ unsigned xb_add(unsigned* p, unsigned v) { return __hip_atomic_fetch_add(p, v, __ATOMIC_RELAXED, __HIP_MEMORY_SCOPE_AGENT); }
__device__ __forceinline__ unsigned xb_xcc_id() { return (unsigned)__builtin_amdgcn_s_getreg((3 << 11) | 20) & 0xFu; }
#define XB_SPIN(cond, bar) do { unsigned _sp = 0; while (cond) { __builtin_amdgcn_s_sleep(1); \
    if ((++_sp & 255u) == 0u) { if (xb_ld(&(bar)[XB_TMO])) break; if (_sp > XB_SPIN_CAP) { atomicAdd(&(bar)[XB_TMO], 1u); break; } } } } while (0)

struct XcdBarrier {
    unsigned* bar; unsigned x;
    volatile LAS unsigned* st;
};

__device__ __forceinline__ XcdBarrier xcd_barrier_post(unsigned* bar, volatile LAS unsigned* st) {
    XcdBarrier b; b.bar = bar; b.x = xb_xcc_id(); b.st = st;
    if (threadIdx.x == 0) (void)xb_add(&bar[XB_XCNT(b.x)], 1u);
    return b;
}
__device__ __forceinline__ void xcd_barrier_complete(unsigned* bar, unsigned x, unsigned& nloc, unsigned& nx) {
    const unsigned G = gridDim.x * gridDim.y * gridDim.z;
    unsigned sum, cnt, mine, sp = 0u;
    for (;;) {
        sum = 0u; cnt = 0u; mine = 0u;
#pragma unroll
        for (unsigned j = 0; j < 16; ++j) { const unsigned c = xb_ld(&bar[XB_XCNT(j)]); sum += c; cnt += (c > 0u) ? 1u : 0u; mine = (j == x) ? c : mine; }
        if (sum == G) break;
        __builtin_amdgcn_s_sleep(1);
        if ((++sp & 255u) == 0u) { if (xb_ld(&bar[XB_TMO])) break; if (sp > XB_SPIN_CAP) { atomicAdd(&bar[XB_TMO], 1u); break; } }
    }
    nloc = mine > 0u ? mine : 1u; nx = cnt > 0u ? cnt : 1u;
}

__device__ __forceinline__ void xcd_barrier(const XcdBarrier& b) {
    asm volatile("s_waitcnt vmcnt(0)" ::: "memory");
    __syncthreads();
    if (threadIdx.x == 0) {
        unsigned* bar = b.bar;
        __builtin_amdgcn_s_waitcnt(0);
        unsigned nloc = b.st[0], nx = b.st[1];
        if (nloc == 0u) { xcd_barrier_complete(bar, b.x, nloc, nx); b.st[0] = nloc; b.st[1] = nx; }
        const unsigned old = xb_add(&bar[XB_XSUB(b.x)], 1u);
        const unsigned gen = old / nloc;
        if (old + 1u == (gen + 1u) * nloc) {
            __builtin_amdgcn_fence(__ATOMIC_RELEASE, "agent");
            asm volatile("s_waitcnt vmcnt(0)" ::: "memory");
            const unsigned og = xb_add(&bar[XB_TOP], 1u);
            const unsigned tg = og / nx;
            if (og + 1u == (tg + 1u) * nx) xb_add(&bar[XB_TOPGEN], 1u);
            else XB_SPIN(xb_ld(&bar[XB_TOPGEN]) == tg, bar);
            __builtin_amdgcn_fence(__ATOMIC_ACQUIRE, "agent");
            xb_add(&bar[XB_XGEN(b.x)], 1u);
            asm volatile("s_waitcnt vmcnt(0)" ::: "memory");
        } else {
            XB_SPIN(xb_ld(&bar[XB_XGEN(b.x)]) == gen, bar);
            __builtin_amdgcn_fence(__ATOMIC_ACQUIRE, "agent");
            asm volatile("s_waitcnt vmcnt(0)" ::: "memory");
        }
    }
    __syncthreads();
}
__global__ void __launch_bounds__(NTHREADS, 2) fwd_kernel(Args args) {
    extern __shared__ __attribute__((aligned(16))) unsigned char lds[];
    Frame F;
    F.lds = (LAS unsigned char*)lds;
    F.tid = threadIdx.x; F.lane = F.tid & 63; F.wave = __builtin_amdgcn_readfirstlane(F.tid >> 6);
    F.G = gridDim.x; { const int bx = blockIdx.x; F.vcu = (F.G % 8 == 0) ? (bx % 8) * (F.G / 8) + bx / 8 : bx; }
    unsigned char* ws = args.ws;
    const int lo = args.ph_lo, hi = args.ph_hi;
#if MK_N_LAUNCHES == 1
    volatile LAS unsigned* MISC = (volatile LAS unsigned*)(F.lds + MISC_OFF);
    if (F.tid < 64) MISC[F.tid] = 0u;
    __syncthreads();
    XcdBarrier bar = xcd_barrier_post((unsigned*)(ws + WS_CTL) + CW_BAR, MISC);
#if USE_CG_SYNC
    cg::grid_group grid = cg::this_grid();
#define GRID_BAR() grid.sync()
#else
#define GRID_BAR() xcd_barrier(bar)
#endif
#else
#define GRID_BAR() do {} while (0)
#endif
#ifdef PROBE_TS
#define TSTAMP(k) do { if (F.vcu == 0 && F.tid == 0) ((volatile LAS unsigned*)(F.lds + MISC_OFF))[16 + (k)] = (unsigned)__builtin_amdgcn_s_memrealtime(); } while (0)
#else
#define TSTAMP(k) do {} while (0)
#endif
#define IN(k) (lo <= (k) && (k) < hi)
#ifndef PROBE_MASK
#define PROBE_MASK 0
#endif
#define NREP(k) (1 + ((PROBE_MASK >> (k)) & 1))
#define LASTREP(k) (rep_ + 1 == NREP(k))
#define FORREP(k) for (int rep_ = 0; rep_ < NREP(k); ++rep_, (rep_ < NREP(k) ? (GRID_BAR(), 0) : 0))
    bf16* XD = (bf16*)(ws + WS_DUMMY);
#ifdef PROBE_BAR2
#define SEAM(k) do { if (IN(k) && IN((k) + 1)) { GRID_BAR(); GRID_BAR(); } } while (0)
#else
#define SEAM(k) do { if (IN(k) && IN((k) + 1)) { GRID_BAR(); TSTAMP((k) + 1); } } while (0)
#endif
    const float* mod = (const float*)(ws + WS_MOD);
    bf16* X = (bf16*)(ws + WS_X); bf16* H = (bf16*)(ws + WS_H);
    const float* x_in = args.in[I_X];

    TSTAMP(0);
    if (IN(0)) {
#if (PROBE_MASK >> 0) & 1
        { p0_prologue(F, args); }
        GRID_BAR();
#endif
        { p0_prologue(F, args); }
    } SEAM(0);
    if (IN(1)) {
#if (PROBE_MASK >> 1) & 1
        { norm_phase(F, x_in, args.in[I_NORMG] + 0 * D, mod + 0 * D, mod + 1 * D, H); }
        GRID_BAR();
#endif
        { norm_phase(F, x_in, args.in[I_NORMG] + 0 * D, mod + 0 * D, mod + 1 * D, H); }
    } SEAM(1);
    if (IN(2)) {
#if (PROBE_MASK >> 2) & 1
        { pg8::Gemm g{H, (const bf16*)(ws + WS_WS5IN), M, D, D}; pg8::StaticOrder S; S.init(M, D, F.G, (int)blockIdx.x);
        pg8::EpiS5U E{(bf16*)(ws + WS_UG)}; pg8::gemm_phase<pg8::EpiS5U, pg8::StaticOrder, true, true>(F.lds, g, S, E); }
        GRID_BAR();
#endif
        { pg8::Gemm g{H, (const bf16*)(ws + WS_WS5IN), M, D, D}; pg8::StaticOrder S; S.init(M, D, F.G, (int)blockIdx.x);
        pg8::EpiS5U E{(bf16*)(ws + WS_UG)}; pg8::gemm_phase<pg8::EpiS5U, pg8::StaticOrder, true, true>(F.lds, g, S, E); }
    } SEAM(2);
    if (IN(3)) {
#if (PROBE_MASK >> 3) & 1
        { for (int it = F.vcu; it < BATCH * S5G; it += F.G) s5_item(F, args, it); }
        GRID_BAR();
#endif
        { for (int it = F.vcu; it < BATCH * S5G; it += F.G) s5_item(F, args, it); }
    } SEAM(3);
    if (IN(4)) {
#if (PROBE_MASK >> 4) & 1
        { pg8::Gemm g{(const bf16*)(ws + WS_Y), (const bf16*)(ws + WS_WGLU), M, 2 * D, D}; pg8::StaticOrder S; S.init(M, 2 * D, F.G, (int)blockIdx.x);
        pg8::EpiGluRes E{x_in, X, mod + 2 * D}; pg8::gemm_phase<pg8::EpiGluRes, pg8::StaticOrder, true, true>(F.lds, g, S, E); }
        GRID_BAR();
#endif
        { pg8::Gemm g{(const bf16*)(ws + WS_Y), (const bf16*)(ws + WS_WGLU), M, 2 * D, D}; pg8::StaticOrder S; S.init(M, 2 * D, F.G, (int)blockIdx.x);
        pg8::EpiGluRes E{x_in, X, mod + 2 * D}; pg8::gemm_phase<pg8::EpiGluRes, pg8::StaticOrder, true, true>(F.lds, g, S, E); }
    } SEAM(4);
    if (IN(5)) {
#if (PROBE_MASK >> 5) & 1
        { norm_phase(F, X, args.in[I_NORMG] + 1 * D, mod + 3 * D, mod + 4 * D, H); }
        GRID_BAR();
#endif
        { norm_phase(F, X, args.in[I_NORMG] + 1 * D, mod + 3 * D, mod + 4 * D, H); }
    } SEAM(5);
    if (IN(6)) {
#if (PROBE_MASK >> 6) & 1
        { pg8::Gemm g{H, (const bf16*)(ws + WS_WGU0), M, 2 * FFH, D}; pg8::StaticOrder S; S.init(M, 2 * FFH, F.G, (int)blockIdx.x);
        pg8::EpiSwiGlu E{(bf16*)(ws + WS_HID), FFH}; pg8::gemm_phase<pg8::EpiSwiGlu, pg8::StaticOrder, true, true>(F.lds, g, S, E); }
        GRID_BAR();
#endif
        { pg8::Gemm g{H, (const bf16*)(ws + WS_WGU0), M, 2 * FFH, D}; pg8::StaticOrder S; S.init(M, 2 * FFH, F.G, (int)blockIdx.x);
        pg8::EpiSwiGlu E{(bf16*)(ws + WS_HID), FFH}; pg8::gemm_phase<pg8::EpiSwiGlu, pg8::StaticOrder, true, true>(F.lds, g, S, E); }
    } SEAM(6);
    if (IN(7)) {
#if (PROBE_MASK >> 7) & 1
        { pg8::Gemm g{(const bf16*)(ws + WS_HID), (const bf16*)(ws + WS_WDN0), M, D, FFH}; pg8::StaticOrder S; S.init(M, D, F.G, (int)blockIdx.x);
        pg8::EpiRes E{X, XD, mod + 5 * D}; pg8::gemm_phase<pg8::EpiRes, pg8::StaticOrder, true, true>(F.lds, g, S, E); }
        GRID_BAR();
#endif
        { pg8::Gemm g{(const bf16*)(ws + WS_HID), (const bf16*)(ws + WS_WDN0), M, D, FFH}; pg8::StaticOrder S; S.init(M, D, F.G, (int)blockIdx.x);
        pg8::EpiRes E{X, X, mod + 5 * D}; pg8::gemm_phase<pg8::EpiRes, pg8::StaticOrder, true, true>(F.lds, g, S, E); }
    } SEAM(7);
    const float* mod1 = mod + 4 * NMOD;
    if (IN(8)) {
#if (PROBE_MASK >> 8) & 1
        { norm_phase(F, X, args.in[I_NORMG] + 2 * D, mod1 + 0 * D, mod1 + 1 * D, H); }
        GRID_BAR();
#endif
        { norm_phase(F, X, args.in[I_NORMG] + 2 * D, mod1 + 0 * D, mod1 + 1 * D, H); }
    } SEAM(8);
    if (IN(9)) {
#if (PROBE_MASK >> 9) & 1
        { pg8::Gemm g{H, (const bf16*)(ws + WS_WLIN), M, 2 * LRUW, D}; pg8::StaticOrder S; S.init(M, 2 * LRUW, F.G, (int)blockIdx.x);
        pg8::EpiLruIn E{(bf16*)(ws + WS_GG), (bf16*)(ws + WS_XB)}; pg8::gemm_phase<pg8::EpiLruIn, pg8::StaticOrder, true, true>(F.lds, g, S, E); }
        GRID_BAR();
#endif
        { pg8::Gemm g{H, (const bf16*)(ws + WS_WLIN), M, 2 * LRUW, D}; pg8::StaticOrder S; S.init(M, 2 * LRUW, F.G, (int)blockIdx.x);
        pg8::EpiLruIn E{(bf16*)(ws + WS_GG), (bf16*)(ws + WS_XB)}; pg8::gemm_phase<pg8::EpiLruIn, pg8::StaticOrder, true, true>(F.lds, g, S, E); }
    } SEAM(9);
#ifdef PROBE_LRUA
    if (IN(10)) { lruA_phase(F, args); GRID_BAR(); }
#endif
    if (IN(10)) { lruA_phase(F, args); } SEAM(10);
    if (IN(11)) {
#if (PROBE_MASK >> 11) & 1
        { lruB_phase(F, args); }
        GRID_BAR();
#endif
        { lruB_phase(F, args); }
    } SEAM(11);
    if (IN(12)) {
#if (PROBE_MASK >> 12) & 1
        { pg8::Gemm g{(const bf16*)(ws + WS_YL), (const bf16*)(ws + WS_WLOUT), M, D, LRUW}; pg8::StaticOrder S; S.init(M, D, F.G, (int)blockIdx.x);
        pg8::EpiRes E{X, XD, mod1 + 2 * D}; pg8::gemm_phase<pg8::EpiRes, pg8::StaticOrder, true, true>(F.lds, g, S, E); }
        GRID_BAR();
#endif
        { pg8::Gemm g{(const bf16*)(ws + WS_YL), (const bf16*)(ws + WS_WLOUT), M, D, LRUW}; pg8::StaticOrder S; S.init(M, D, F.G, (int)blockIdx.x);
        pg8::EpiRes E{X, X, mod1 + 2 * D}; pg8::gemm_phase<pg8::EpiRes, pg8::StaticOrder, true, true>(F.lds, g, S, E); }
    } SEAM(12);
    if (IN(13)) {
#if (PROBE_MASK >> 13) & 1
        { norm_phase(F, X, args.in[I_NORMG] + 3 * D, mod1 + 3 * D, mod1 + 4 * D, H); }
        GRID_BAR();
#endif
        { norm_phase(F, X, args.in[I_NORMG] + 3 * D, mod1 + 3 * D, mod1 + 4 * D, H); }
    } SEAM(13);
    if (IN(14)) {
#if (PROBE_MASK >> 14) & 1
        { pg8::Gemm g{H, (const bf16*)(ws + WS_WGU1), M, 2 * FFH, D}; pg8::StaticOrder S; S.init(M, 2 * FFH, F.G, (int)blockIdx.x);
        pg8::EpiSwiGlu E{(bf16*)(ws + WS_HID), FFH}; pg8::gemm_phase<pg8::EpiSwiGlu, pg8::StaticOrder, true, true>(F.lds, g, S, E); }
        GRID_BAR();
#endif
        { pg8::Gemm g{H, (const bf16*)(ws + WS_WGU1), M, 2 * FFH, D}; pg8::StaticOrder S; S.init(M, 2 * FFH, F.G, (int)blockIdx.x);
        pg8::EpiSwiGlu E{(bf16*)(ws + WS_HID), FFH}; pg8::gemm_phase<pg8::EpiSwiGlu, pg8::StaticOrder, true, true>(F.lds, g, S, E); }
    } SEAM(14);
    if (IN(15)) {
#if (PROBE_MASK >> 15) & 1
        { pg8::Gemm g{(const bf16*)(ws + WS_HID), (const bf16*)(ws + WS_WDN1), M, D, FFH}; pg8::StaticOrder S; S.init(M, D, F.G, (int)blockIdx.x);
        pg8::EpiRes E{X, XD, mod1 + 5 * D}; pg8::gemm_phase<pg8::EpiRes, pg8::StaticOrder, true, true>(F.lds, g, S, E); }
        GRID_BAR();
#endif
        { pg8::Gemm g{(const bf16*)(ws + WS_HID), (const bf16*)(ws + WS_WDN1), M, D, FFH}; pg8::StaticOrder S; S.init(M, D, F.G, (int)blockIdx.x);
        pg8::EpiRes E{X, X, mod1 + 5 * D}; pg8::gemm_phase<pg8::EpiRes, pg8::StaticOrder, true, true>(F.lds, g, S, E); }
    } SEAM(15);
    if (IN(16)) { final_norm_phase(F, X, args.in[I_FINALG], args.out); }
#ifdef PROBE_TS
    GRID_BAR(); TSTAMP(17);
    if (F.vcu == 0) { volatile LAS unsigned* ts = (volatile LAS unsigned*)(F.lds + MISC_OFF) + 16; __syncthreads();
#ifdef PROBE_TS_ACC
        const unsigned dt = ts[24 + PROBE_TS_ACC];
#else
        const unsigned dt = ts[PROBE_TS_HI] - ts[PROBE_TS_LO];
#endif
        const int n = (int)((float)dt * PROBE_TS_SCALE);
        for (int i = F.tid; i < n && i < 60000; i += NTHREADS) args.out[i] += 0.2f; }
#endif
#undef IN
#undef SEAM
}

extern "C" void kernel_launch(void* const* d_in, const int* in_sizes, int n_in, void* d_out, int out_size, void* d_ws, size_t ws_size, hipStream_t stream) {
    static int grid = 0;
    if (grid == 0) {
        if (n_in != 27 || out_size != M * D || ws_size < WS_END) { fprintf(stderr, "kernel_launch: unexpected shapes (n_in %d out %d ws %zu)\n", n_in, out_size, ws_size); grid = -1; return; }
        int dev = 0, cus = 0, per_cu = 0;
        if (hipGetDevice(&dev) != hipSuccess || hipDeviceGetAttribute(&cus, hipDeviceAttributeMultiprocessorCount, dev) != hipSuccess) { grid = -1; return; }
        if (hipFuncSetAttribute((const void*)fwd_kernel, hipFuncAttributeMaxDynamicSharedMemorySize, LDS_BYTES) != hipSuccess) { fprintf(stderr, "kernel_launch: hipFuncSetAttribute failed\n"); grid = -1; return; }
        if (hipOccupancyMaxActiveBlocksPerMultiprocessor(&per_cu, (const void*)fwd_kernel, NTHREADS, LDS_BYTES) != hipSuccess || per_cu < 1) { fprintf(stderr, "kernel_launch: occupancy query says %d\n", per_cu); per_cu = 1; }
        (void)hipGetLastError();
        grid = cus;
        if (grid > 256) grid = 256;
        fprintf(stderr, "kernel_launch: grid %d (cus %d, per_cu %d)\n", grid, cus, per_cu);
    }
    if (grid < 0) return;
#if 1
    if (hipMemsetAsync((char*)d_ws + WS_CTL, 0, CTL_ZERO_BYTES, stream) != hipSuccess) { fprintf(stderr, "kernel_launch: memset failed\n"); return; }
#endif
    Args a{};
    for (int i = 0; i < 27; ++i) a.in[i] = (const float*)d_in[i];
    a.out = (float*)d_out; a.ws = (unsigned char*)d_ws;
#if MK_N_LAUNCHES == 1
    a.ph_lo = 0; a.ph_hi = NPHASES;
    void* kargs[] = {&a};
    hipError_t e = hipLaunchCooperativeKernel((const void*)fwd_kernel, dim3(grid), dim3(NTHREADS), kargs, LDS_BYTES, stream);
    if (e != hipSuccess) fprintf(stderr, "kernel_launch: cooperative launch failed: %s\n", hipGetErrorString(e));
#else
    for (int ph = 0; ph < NPHASES; ++ph) { a.ph_lo = ph; a.ph_hi = ph + 1;
        hipLaunchKernelGGL(fwd_kernel, dim3(grid), dim3(NTHREADS), LDS_BYTES, stream, a);
        const hipError_t le = hipPeekAtLastError(); if (le != hipSuccess) { fprintf(stderr, "kernel_launch: launch %d failed: %s\n", ph, hipGetErrorName(le)); break; } }
#endif
}
```
